# Optimizing an MI355X kernel written in HIP

```python
import jax, jax.numpy as jnp
from jax import lax
import numpy as np

D_MODEL = 1024
BATCH = 8
SEQ = 2048
DEPTH = 1

N_META = 16
GRID_W = 64
NA_WIN_ROWS = 8
NA_WIN_COLS = 16
NA_HEADS = 8
NA_HEAD_DIM = 64
NA_WIDTH = NA_HEADS * NA_HEAD_DIM
GLA_HEADS = 4
GLA_DK = 64
GLA_DV = 128
GLA_KW = GLA_HEADS * GLA_DK
GLA_VW = GLA_HEADS * GLA_DV
GLA_GATE_RANK = 16
GLA_GATE_TAU = 16.0
GLA_CHUNK = 64
MIX_WIDTH = NA_WIDTH + GLA_VW
IN_COLS = 3 * NA_WIDTH + 2 * GLA_KW + 2 * GLA_VW + 2 * GLA_GATE_RANK
D_FF = 2816
CONV_W = 3
RMS_EPS = 1e-6

kernel_name = 'hybrid_na_gla_convffn_encoder'


def rmsnorm(x, g):
    xf = x.astype(jnp.float32)
    y = xf * lax.rsqrt(jnp.mean(xf * xf, axis=-1, keepdims=True) + RMS_EPS)
    return (y * g.astype(jnp.float32)).astype(x.dtype)


def neighbourhood_attention(q, k, v, rpb):
    B, L, H, dh = q.shape
    T = L - N_META
    W = GRID_W
    R = T // W
    kh = min(NA_WIN_ROWS, R)
    kw = NA_WIN_COLS
    q = q * (dh ** -0.5)
    qm, km, vm = q[:, :N_META], k[:, :N_META], v[:, :N_META]

    def grid(t):
        return t[:, N_META:].reshape(B, R, W, H, dh).transpose(0, 3, 1, 2, 4)

    qg, kg, vg = grid(q), grid(k), grid(v)
    rs = jnp.clip(jnp.arange(R) - kh // 2, 0, R - kh)
    row_idx = rs[:, None] + jnp.arange(kh)[None, :]
    k_rows = kg[:, :, row_idx]
    v_rows = vg[:, :, row_idx]
    cq = jnp.arange(W)
    cs = jnp.clip(cq - kw // 2, 0, W - kw)
    in_win = (cq[None, :] >= cs[:, None]) & (cq[None, :] < cs[:, None] + kw)
    dr = row_idx - jnp.arange(R)[:, None] + (NA_WIN_ROWS - 1)
    dc = jnp.clip(cq[None, :] - cq[:, None], -(kw - 1), kw - 1) + (NA_WIN_COLS - 1)
    bias = rpb[:, dr[:, None, :, None], dc[None, :, None, :]]

    s_loc = jnp.einsum('bhrcd,bhrikd->bhrcik', qg, k_rows).astype(jnp.float32) + bias.astype(jnp.float32)
    s_loc = jnp.where(in_win[:, None, :], s_loc, -jnp.inf)
    s_meta = jnp.einsum('bhrcd,bmhd->bhrcm', qg, km).astype(jnp.float32)
    s_all = jnp.concatenate([s_loc.reshape(B, H, R, W, kh * W), s_meta], axis=-1)
    p = jax.nn.softmax(s_all, axis=-1).astype(v.dtype)
    p_loc = p[..., :kh * W].reshape(B, H, R, W, kh, W)
    p_meta = p[..., kh * W:]
    og = (jnp.einsum('bhrcik,bhrikd->bhrcd', p_loc, v_rows)
          + jnp.einsum('bhrcm,bmhd->bhrcd', p_meta, vm))
    og = og.transpose(0, 2, 3, 1, 4).reshape(B, T, H * dh)
    sm = jnp.einsum('bqhd,bkhd->bhqk', qm, km).astype(jnp.float32)
    pm = jax.nn.softmax(sm, axis=-1).astype(v.dtype)
    om = jnp.einsum('bhqk,bkhd->bqhd', pm, vm).reshape(B, N_META, H * dh)
    return jnp.concatenate([om, og], axis=1)


def gla_chunked(q, k, v, log_a, strict):
    C = q.shape[-2]
    b = jnp.cumsum(log_a, axis=-2)
    b_last = b[..., -1:, :]
    q_dec = q * jnp.exp(b)
    k_inv = k * jnp.exp(-b)
    k_end = k * jnp.exp(b_last - b)
    mask = jnp.tril(jnp.ones((C, C), dtype=bool), k=-1 if strict else 0)
    a = jnp.where(mask, jnp.einsum('bhncd,bhnsd->bhncs', q_dec, k_inv), 0.0)
    o = jnp.einsum('bhncs,bhnse->bhnce', a, v)
    ds = jnp.einsum('bhncd,bhnce->nbhde', k_end, v)
    decay = jnp.exp(b_last[..., 0, :]).transpose(2, 0, 1, 3)

    def step(s, inp):
        dec, d = inp
        return dec[..., None] * s + d, s

    s0 = jnp.zeros(ds.shape[1:], ds.dtype)
    _, s_prev = lax.scan(step, s0, (decay, ds))
    return o + jnp.einsum('bhncd,nbhde->bhnce', q_dec, s_prev)


def gla_bidirectional(q, k, v, g, z, up_f, bias_f, up_b, bias_b, out_gain):
    B, L, _ = q.shape
    H, dk, dv, C = GLA_HEADS, GLA_DK, GLA_DV, GLA_CHUNK
    f32 = jnp.float32
    pad = (-N_META) % C
    Lp = L + pad
    N = Lp // C
    la_f = jax.nn.log_sigmoid((z[..., :GLA_GATE_RANK] @ up_f + bias_f).astype(f32)) / GLA_GATE_TAU
    la_b = jax.nn.log_sigmoid((z[..., GLA_GATE_RANK:] @ up_b + bias_b).astype(f32)) / GLA_GATE_TAU

    def pad_seq(t, d):
        return jnp.pad(t.astype(f32).reshape(B, L, H, d), ((0, 0), (pad, 0), (0, 0), (0, 0)))

    def chunk(t):
        return t.reshape(B, N, C, H, t.shape[-1]).transpose(0, 3, 1, 2, 4)

    def unchunk(t):
        return t.transpose(0, 2, 3, 1, 4).reshape(B, Lp, H, t.shape[-1])

    qp = pad_seq(q * (dk ** -0.5), dk)
    kp = pad_seq(k, dk)
    vp = pad_seq(v, dv)
    lfp = pad_seq(la_f, dk)
    lbp = pad_seq(la_b, dk)
    o_f = unchunk(gla_chunked(chunk(qp), chunk(kp), chunk(vp), chunk(lfp), False))
    rev = lambda t: t[:, ::-1]
    o_b = rev(unchunk(gla_chunked(chunk(rev(qp)), chunk(rev(kp)), chunk(rev(vp)), chunk(rev(lbp)), True)))
    o = (o_f + o_b)[:, pad:].astype(q.dtype)
    o = rmsnorm(o, out_gain) * jax.nn.silu(g.reshape(B, L, H, dv))
    return o.reshape(B, L, H * dv)


def hybrid_layer(h, norm_mix_pre, w_in, rpb, na_gain, up_f, bias_f, up_b, bias_b, gla_gain,
                 w_o, norm_mix_post, norm_ffn_pre, w_ffn_in, conv_w, conv_b, w_ffn_out, norm_ffn_post):
    B, L, _ = h.shape
    u = rmsnorm(h, norm_mix_pre)
    proj = u @ w_in
    sizes = [NA_WIDTH, NA_WIDTH, NA_WIDTH, GLA_KW, GLA_KW, GLA_VW, GLA_VW, 2 * GLA_GATE_RANK]
    offs = np.cumsum([0] + sizes)
    parts = [proj[..., int(offs[i]):int(offs[i + 1])] for i in range(len(sizes))]
    q_na, k_na, v_na, q_gl, k_gl, v_gl, g_gl, z_gl = parts
    shp = (B, L, NA_HEADS, NA_HEAD_DIM)
    o_na = neighbourhood_attention(q_na.reshape(shp), k_na.reshape(shp), v_na.reshape(shp), rpb)
    o_na = rmsnorm(o_na, na_gain)
    o_gl = gla_bidirectional(q_gl, k_gl, v_gl, g_gl, z_gl, up_f, bias_f, up_b, bias_b, gla_gain)
    mix = jnp.concatenate([o_na, o_gl], axis=-1) @ w_o
    h = h + rmsnorm(mix, norm_mix_post)
    a = rmsnorm(h, norm_ffn_pre) @ w_ffn_in
    half = CONV_W // 2
    ap = jnp.pad(a, ((0, 0), (half, half), (0, 0)))
    a = sum(ap[:, j:j + L] * conv_w[j] for j in range(CONV_W)) + conv_b
    val, gate = a[..., :D_FF], a[..., D_FF:]
    y = (jax.nn.gelu(gate, approximate=True) * val) @ w_ffn_out
    return h + rmsnorm(y, norm_ffn_post)


def setup_inputs(seed: int = 0) -> dict:
    key = jax.random.key(seed)
    ks = jax.random.split(key, 20)
    f32 = jnp.float32

    def nrm(k, shape, scale):
        return jax.random.normal(k, shape, f32) * scale

    def gain(k, shape):
        return 1.0 + 0.1 * jax.random.normal(k, shape, f32)

    return {
        'x': nrm(ks[0], (BATCH, SEQ, D_MODEL), 1.0),
        'meta_tokens': nrm(ks[1], (N_META, D_MODEL), 1.0),
        'norm_mix_pre': gain(ks[2], (DEPTH, D_MODEL)),
        'w_in': nrm(ks[3], (DEPTH, D_MODEL, IN_COLS), D_MODEL ** -0.5),
        'na_rel_bias': nrm(ks[4], (DEPTH, NA_HEADS, 2 * NA_WIN_ROWS - 1, 2 * NA_WIN_COLS - 1), 0.5),
        'na_out_gain': gain(ks[5], (DEPTH, NA_WIDTH)),
        'gla_gate_up_fwd': nrm(ks[6], (DEPTH, GLA_GATE_RANK, GLA_KW), GLA_GATE_RANK ** -0.5),
        'gla_gate_bias_fwd': nrm(ks[7], (DEPTH, GLA_KW), 0.5),
        'gla_gate_up_bwd': nrm(ks[8], (DEPTH, GLA_GATE_RANK, GLA_KW), GLA_GATE_RANK ** -0.5),
        'gla_gate_bias_bwd': nrm(ks[9], (DEPTH, GLA_KW), 0.5),
        'gla_out_gain': gain(ks[10], (DEPTH, GLA_DV)),
        'w_o': nrm(ks[11], (DEPTH, MIX_WIDTH, D_MODEL), MIX_WIDTH ** -0.5),
        'norm_mix_post': gain(ks[12], (DEPTH, D_MODEL)),
        'norm_ffn_pre': gain(ks[13], (DEPTH, D_MODEL)),
        'w_ffn_in': nrm(ks[14], (DEPTH, D_MODEL, 2 * D_FF), D_MODEL ** -0.5),
        'ffn_conv_w': nrm(ks[15], (DEPTH, CONV_W, 2 * D_FF), CONV_W ** -0.5),
        'ffn_conv_b': nrm(ks[16], (DEPTH, 2 * D_FF), 0.02),
        'w_ffn_out': nrm(ks[17], (DEPTH, D_FF, D_MODEL), D_FF ** -0.5),
        'norm_ffn_post': gain(ks[18], (DEPTH, D_MODEL)),
    }


def reference(x, meta_tokens, norm_mix_pre, w_in, na_rel_bias, na_out_gain, gla_gate_up_fwd,
              gla_gate_bias_fwd, gla_gate_up_bwd, gla_gate_bias_bwd, gla_out_gain, w_o, norm_mix_post,
              norm_ffn_pre, w_ffn_in, ffn_conv_w, ffn_conv_b, w_ffn_out, norm_ffn_post):
    B = x.shape[0]
    meta = jnp.broadcast_to(meta_tokens.astype(x.dtype)[None], (B, N_META, x.shape[-1]))
    h = jnp.concatenate([meta, x], axis=1)
    for l in range(DEPTH):
        h = hybrid_layer(h, norm_mix_pre[l], w_in[l], na_rel_bias[l], na_out_gain[l],
                         gla_gate_up_fwd[l], gla_gate_bias_fwd[l], gla_gate_up_bwd[l], gla_gate_bias_bwd[l],
                         gla_out_gain[l], w_o[l], norm_mix_post[l], norm_ffn_pre[l], w_ffn_in[l],
                         ffn_conv_w[l], ffn_conv_b[l], w_ffn_out[l], norm_ffn_post[l])
    return h[:, N_META:]
```

```cpp
#include <hip/hip_runtime.h>
#include <cstdint>
#include <cstdio>

typedef unsigned short bf16_t;
typedef float f32x4 __attribute__((ext_vector_type(4)));
typedef unsigned u32x4 __attribute__((ext_vector_type(4)));
typedef unsigned u32x2 __attribute__((ext_vector_type(2)));

constexpr int NB = 8, SEQ = 2048, DM = 1024, NMETA = 16;
constexpr int MR = NB * SEQ;
constexpr int MROWS = 16640;
constexpr int RMETA = MR;
constexpr int PN_LD = 2304;
constexpr int C_QNA = 0, C_KNA = 512, C_QGL = 1024, C_KGL = 1280, C_G = 1536, C_Z = 2048, PN_VALID = 2080;
constexpr int VT_LD = MROWS;
constexpr int INC = 3104, DFF = 2816, FH = 1408;
constexpr int NCH = 33;
constexpr float EPS = 1e-6f;
constexpr int MX = MR + 8;

constexpr size_t MiB = 1u << 20;
constexpr size_t WS_CTL = 0;
constexpr size_t WS_WTN = 1 * MiB;
constexpr size_t WS_WTV = WS_WTN + (size_t)2304 * 1024 * 2;
constexpr size_t WS_WTO = WS_WTV + (size_t)1024 * 1024 * 2;
constexpr size_t WS_WF1 = WS_WTO + (size_t)1024 * 1024 * 2;
constexpr size_t WS_WF2 = WS_WF1 + (size_t)5632 * 1024 * 2;
constexpr size_t WS_DEC = 27 * MiB;
constexpr size_t WS_U   = 30 * MiB;
constexpr size_t WS_PN  = 63 * MiB;
constexpr size_t WS_VT  = 137 * MiB;
constexpr size_t WS_MIX = 170 * MiB;
constexpr size_t WS_DSS = 203 * MiB;
constexpr size_t WS_END = 236 * MiB;
constexpr size_t WS_Y   = 63 * MiB;
constexpr size_t WS_ARAW = 63 * MiB;
constexpr size_t WS_ACT = 152 * MiB;
static_assert(WS_WF2 + (size_t)1024 * 2816 * 2 <= WS_DEC, "weights");
static_assert(WS_ARAW + (size_t)MX * 2816 * 2 <= WS_ACT, "araw");
static_assert(WS_ACT + (size_t)MR * 2816 * 2 <= 256 * MiB, "act");
static_assert(WS_MIX + (size_t)MX * 1024 * 2 <= WS_DSS, "mix");

constexpr int NTHR = 512, NWAVE = 8;
constexpr int LDS_BYTES = 147456;

struct Params {
    const float* x; const float* meta; const float* g_pre; const float* w_in; const float* rpb; const float* na_gain;
    const float* up_f; const float* bias_f; const float* up_b; const float* bias_b; const float* gla_gain; const float* w_o;
    const float* g_post; const float* g_ffn_pre; const float* w_f1; const float* conv_w; const float* conv_b; const float* w_f2; const float* g_ffn_post;
    float* out; unsigned char* ws; int phase; int pad;
};

__device__ __forceinline__ float bf2f(bf16_t v) { return __uint_as_float(((unsigned)v) << 16); }
__device__ __forceinline__ unsigned f2bf(float f) { unsigned u = __float_as_uint(f); return (u + 0x7fffu + ((u >> 16) & 1u)) >> 16; }
__device__ __forceinline__ unsigned pk2(float lo, float hi) { return f2bf(lo) | (f2bf(hi) << 16); }
__device__ __forceinline__ float wave_sum(float v) {
#pragma unroll
    for (int o = 1; o < 64; o <<= 1) v += __shfl_xor(v, o);
    return v;
}
__device__ __forceinline__ float wave_max(float v) {
#pragma unroll
    for (int o = 1; o < 64; o <<= 1) v = fmaxf(v, __shfl_xor(v, o));
    return v;
}
__device__ __forceinline__ float log_sigmoid(float x) { return fminf(x, 0.f) - log1pf(expf(-fabsf(x))); }
__device__ __forceinline__ float silu(float x) { return x / (1.f + expf(-x)); }
__device__ __forceinline__ float gelu_tanh(float x) { const float u = 0.7978845608028654f * (x + 0.044715f * x * x * x); return x / (1.f + expf(-2.f * u)); }

__device__ __forceinline__ void transpose_item(const float* W, int ldw, int src_n0, int k0, bf16_t* WT, int K, int dst_row0, float scale, float* scr, int lane) {
#pragma unroll 8
    for (int i = 0; i < 32; ++i) { const int kk = 2 * i + (lane >> 5); scr[kk * 33 + (lane & 31)] = W[(size_t)(k0 + kk) * ldw + src_n0 + (lane & 31)] * scale; }
    __builtin_amdgcn_s_waitcnt(0xc07f); asm volatile("" ::: "memory");
    const int c = lane & 7;
#pragma unroll
    for (int j = 0; j < 4; ++j) { const int n = (lane >> 3) + 8 * j; const float* s = scr + (8 * c) * 33 + n;
        u32x4 o; o.x = pk2(s[0 * 33], s[1 * 33]); o.y = pk2(s[2 * 33], s[3 * 33]); o.z = pk2(s[4 * 33], s[5 * 33]); o.w = pk2(s[6 * 33], s[7 * 33]);
        *(u32x4*)(WT + (size_t)(dst_row0 + n) * K + k0 + 8 * c) = o; }
    __builtin_amdgcn_s_waitcnt(0xc07f); asm volatile("" ::: "memory");
}
__device__ __forceinline__ int wtn_src(int n, float& sc) {
    sc = 1.f;
    if (n < 512) { sc = 0.125f; return n; }
    if (n < 1024) return n;
    if (n < 1280) { sc = 0.125f; return 1536 + (n - 1024); }
    if (n < 1536) return 1792 + (n - 1280);
    if (n < 2048) return 2560 + (n - 1536);
    return 3072 + (n - 2048);
}
__device__ __forceinline__ int wtv_src(int n) { return n < 512 ? 1024 + n : 2048 + (n - 512); }
__device__ __forceinline__ int wf1_src(int n) { const int hf = n / 2816, w = n % 2816; return w < FH ? hf * FH + w : 2816 + hf * FH + (w - FH); }

__device__ void phase_prep(const Params& p, unsigned char* lds, int vb, int nb) {
    const int tid = threadIdx.x, lane = tid & 63, wave = tid >> 6;
    float* scr = (float*)lds + wave * (64 * 33);
    bf16_t* WTN = (bf16_t*)(p.ws + WS_WTN); bf16_t* WTV = (bf16_t*)(p.ws + WS_WTV); bf16_t* WTO = (bf16_t*)(p.ws + WS_WTO);
    bf16_t* WF1 = (bf16_t*)(p.ws + WS_WF1); bf16_t* WF2 = (bf16_t*)(p.ws + WS_WF2); bf16_t* U = (bf16_t*)(p.ws + WS_U);
    const int gw = vb * NWAVE + wave, NGW = nb * NWAVE;
    constexpr int I_N = (2080 / 32) * 16, I_V = (1024 / 32) * 16, I_O = (1024 / 32) * 16, I_F1 = (5632 / 32) * 16, I_F2 = (1024 / 32) * 44;
    constexpr int NIT = I_N + I_V + I_O + I_F1 + I_F2;
    for (int it = gw; it < NIT; it += NGW) {
        int r = it;
        if (r < I_N) { const int nb32 = r / 16, kb = r % 16; float sc; const int src = wtn_src(nb32 * 32, sc); transpose_item(p.w_in, INC, src, kb * 64, WTN, 1024, nb32 * 32, sc, scr, lane); continue; } r -= I_N;
        if (r < I_V) { const int nb32 = r / 16, kb = r % 16; transpose_item(p.w_in, INC, wtv_src(nb32 * 32), kb * 64, WTV, 1024, nb32 * 32, 1.f, scr, lane); continue; } r -= I_V;
        if (r < I_O) { const int nb32 = r / 16, kb = r % 16; transpose_item(p.w_o, 1024, nb32 * 32, kb * 64, WTO, 1024, nb32 * 32, 1.f, scr, lane); continue; } r -= I_O;
        if (r < I_F1) { const int nb32 = r / 16, kb = r % 16; transpose_item(p.w_f1, 2 * DFF, wf1_src(nb32 * 32), kb * 64, WF1, 1024, nb32 * 32, 1.f, scr, lane); continue; } r -= I_F1;
        { const int nb32 = r / 44, kb = r % 44; transpose_item(p.w_f2, 1024, nb32 * 32, kb * 64, WF2, DFF, nb32 * 32, 1.f, scr, lane); }
    }
    for (int i = vb * NTHR + tid; i < (2304 - 2080) * 1024 / 8; i += nb * NTHR) *(u32x4*)(WTN + (size_t)2080 * 1024 + (size_t)i * 8) = (u32x4){0u, 0u, 0u, 0u};
    for (int R = gw; R < MR + NMETA; R += NGW) {
        const float* src = R < MR ? p.x + (size_t)R * DM : p.meta + (size_t)(R - MR) * DM;
        f32x4 v[4]; float s = 0.f;
#pragma unroll
        for (int j = 0; j < 4; ++j) { v[j] = *(const f32x4*)(src + 256 * j + 4 * lane); s += v[j].x * v[j].x + v[j].y * v[j].y + v[j].z * v[j].z + v[j].w * v[j].w; }
        const float rstd = rsqrtf(wave_sum(s) * (1.f / DM) + EPS);
#pragma unroll
        for (int j = 0; j < 4; ++j) { const f32x4 g = *(const f32x4*)(p.g_pre + 256 * j + 4 * lane);
            u32x2 o; o.x = pk2(v[j].x * rstd * g.x, v[j].y * rstd * g.y); o.y = pk2(v[j].z * rstd * g.z, v[j].w * rstd * g.w);
            *(u32x2*)(U + (size_t)R * DM + 256 * j + 4 * lane) = o; }
    }
}

template <class Epi>
__device__ void gemm_valu(const bf16_t* A, int lda, const bf16_t* Bt, int ldb, int M, int N, int K, const Epi& epi, unsigned char* lds, int vb, int nb) {
    float* As = (float*)lds;
    float* Bs = As + 32 * 65;
    const int tid = threadIdx.x, ty = tid >> 4, tx = tid & 15;
    const int tm = (M + 63) / 64, tn = (N + 63) / 64;
    const int lrow = tid >> 3, lk = (tid & 7) * 4;
    for (int tile = vb; tile < tm * tn; tile += nb) {
        const int m0 = (tile / tn) * 64, n0 = (tile % tn) * 64;
        float acc[2][4] = {{0.f, 0.f, 0.f, 0.f}, {0.f, 0.f, 0.f, 0.f}};
        for (int k0 = 0; k0 < K; k0 += 32) {
            { const int m = m0 + lrow; u32x2 w = (u32x2){0u, 0u}; if (m < M) w = *(const u32x2*)(A + (size_t)m * lda + k0 + lk);
              As[(lk + 0) * 65 + lrow] = __uint_as_float(w.x << 16); As[(lk + 1) * 65 + lrow] = __uint_as_float(w.x & 0xffff0000u);
              As[(lk + 2) * 65 + lrow] = __uint_as_float(w.y << 16); As[(lk + 3) * 65 + lrow] = __uint_as_float(w.y & 0xffff0000u); }
            { const int n = n0 + lrow; u32x2 w = (u32x2){0u, 0u}; if (n < N) w = *(const u32x2*)(Bt + (size_t)n * ldb + k0 + lk);
              Bs[(lk + 0) * 65 + lrow] = __uint_as_float(w.x << 16); Bs[(lk + 1) * 65 + lrow] = __uint_as_float(w.x & 0xffff0000u);
              Bs[(lk + 2) * 65 + lrow] = __uint_as_float(w.y << 16); Bs[(lk + 3) * 65 + lrow] = __uint_as_float(w.y & 0xffff0000u); }
            __syncthreads();
#pragma unroll 8
            for (int k = 0; k < 32; ++k) {
                const float a0 = As[k * 65 + ty * 2], a1 = As[k * 65 + ty * 2 + 1];
                const float b0 = Bs[k * 65 + tx * 4], b1 = Bs[k * 65 + tx * 4 + 1], b2 = Bs[k * 65 + tx * 4 + 2], b3 = Bs[k * 65 + tx * 4 + 3];
                acc[0][0] += a0 * b0; acc[0][1] += a0 * b1; acc[0][2] += a0 * b2; acc[0][3] += a0 * b3;
                acc[1][0] += a1 * b0; acc[1][1] += a1 * b1; acc[1][2] += a1 * b2; acc[1][3] += a1 * b3;
            }
            __syncthreads();
        }
#pragma unroll
        for (int i = 0; i < 2; ++i)
#pragma unroll
            for (int j = 0; j < 4; ++j) { const int m = m0 + ty * 2 + i, n = n0 + tx * 4 + j; if (m < M && n < N) epi(m, n, acc[i][j]); }
    }
}
struct EpiPN { bf16_t* PN; bf16_t* VT; __device__ void operator()(int m, int n, float v) const { if (n < PN_VALID) PN[(size_t)m * PN_LD + n] = (bf16_t)f2bf(v); else VT[(size_t)(n - PN_VALID) * VT_LD + m] = (bf16_t)f2bf(v); } };
struct EpiVT { bf16_t* VT; __device__ void operator()(int m, int n, float v) const { VT[(size_t)n * VT_LD + m] = (bf16_t)f2bf(v); } };
struct EpiF32S { float* C; int ldc; __device__ void operator()(int m, int n, float v) const { C[(size_t)m * ldc + n] = v; } };
struct EpiBF { bf16_t* C; int ldc; __device__ void operator()(int m, int n, float v) const { C[(size_t)m * ldc + n] = (bf16_t)f2bf(v); } };

__device__ __forceinline__ int gla_row(int b, int n, int c) { if (n == 0) return c < 48 ? -1 : RMETA + (c - 48); return b * SEQ + (n - 1) * 64 + c; }
__device__ void gla_gates(const Params& p, const bf16_t* PN, int b, int h, int n, float* BF, float* BB, float* ZT  ) {
    const int tid = threadIdx.x;
    for (int i = tid; i < 64 * 32; i += NTHR) { const int c = i >> 5, r = i & 31; const int R = gla_row(b, n, c); ZT[i] = R < 0 ? 0.f : bf2f(PN[(size_t)R * PN_LD + C_Z + r]); }
    __syncthreads();
    for (int i = tid; i < 2 * 64 * 64; i += NTHR) {
        const int dir = i >> 12, c = (i >> 6) & 63, d = i & 63; const int col = h * 64 + d;
        const float* up = dir ? p.up_b : p.up_f; float a = dir ? p.bias_b[col] : p.bias_f[col];
#pragma unroll
        for (int r = 0; r < 16; ++r) a += ZT[c * 32 + dir * 16 + r] * up[r * 256 + col];
        float la = log_sigmoid(a) * (1.f / 16.f);
        if (gla_row(b, n, c) < 0) la = 0.f;
        (dir ? BB : BF)[c * 64 + d] = la;
    }
    __syncthreads();
    if (tid < 64) { float s = 0.f; for (int c = 0; c < 64; ++c) { s += BF[c * 64 + tid]; BF[c * 64 + tid] = s; } }
    else if (tid < 128) { const int d = tid - 64; float s = 0.f; for (int c = 63; c >= 0; --c) { s += BB[c * 64 + d]; BB[c * 64 + d] = s; } }
    __syncthreads();
}
__device__ __forceinline__ size_t dss_idx(int dir, int b, int h, int n) { return ((((size_t)dir * NB + b) * 4 + h) * NCH + n) * 8192; }
__device__ __forceinline__ size_t dec_idx(int dir, int b, int h, int n) { return ((((size_t)dir * NB + b) * 4 + h) * NCH + n) * 64; }

__device__ void phase_gla_ds(const Params& p, unsigned char* lds, int vb, int nb) {
    const bf16_t* PN = (const bf16_t*)(p.ws + WS_PN); const bf16_t* VT = (const bf16_t*)(p.ws + WS_VT);
    bf16_t* DSS = (bf16_t*)(p.ws + WS_DSS); float* DEC = (float*)(p.ws + WS_DEC);
    float* BF = (float*)lds; float* BB = BF + 4096; float* KF = BB + 4096; float* KB = KF + 4096; float* V = KB + 4096; float* ZT = V + 8192;
    const int tid = threadIdx.x;
    for (int item = vb; item < NB * 4 * NCH; item += nb) {
        const int n = item % NCH, h = (item / NCH) & 3, b = item / (NCH * 4);
        gla_gates(p, PN, b, h, n, BF, BB, ZT);
        for (int i = tid; i < 4096; i += NTHR) { const int c = i >> 6, d = i & 63; const int R = gla_row(b, n, c);
            const float k = R < 0 ? 0.f : bf2f(PN[(size_t)R * PN_LD + C_KGL + h * 64 + d]);
            KF[i] = k * expf(BF[63 * 64 + d] - BF[i]); KB[i] = k * expf(BB[d] - BB[i]); }
        for (int i = tid; i < 8192; i += NTHR) { const int e = i >> 6, c = i & 63; const int R = gla_row(b, n, c);
            V[c * 128 + e] = R < 0 ? 0.f : bf2f(VT[(size_t)(512 + h * 128 + e) * VT_LD + R]); }
        __syncthreads();
        { const int dir = tid >> 8, e = tid & 127, dh = (tid >> 7) & 1; const float* KE = dir ? KB : KF;
          float acc[32];
#pragma unroll
          for (int j = 0; j < 32; ++j) acc[j] = 0.f;
          for (int c = 0; c < 64; ++c) { const float vv = V[c * 128 + e];
#pragma unroll
              for (int j = 0; j < 32; ++j) acc[j] += KE[c * 64 + dh * 32 + j] * vv; }
          bf16_t* dst = DSS + dss_idx(dir, b, h, n) + e * 64 + dh * 32;
#pragma unroll
          for (int j = 0; j < 32; j += 8) { u32x4 o; o.x = pk2(acc[j], acc[j + 1]); o.y = pk2(acc[j + 2], acc[j + 3]); o.z = pk2(acc[j + 4], acc[j + 5]); o.w = pk2(acc[j + 6], acc[j + 7]); *(u32x4*)(dst + j) = o; } }
        if (tid < 64) DEC[dec_idx(0, b, h, n) + tid] = expf(BF[63 * 64 + tid]);
        else if (tid < 128) DEC[dec_idx(1, b, h, n) + tid - 64] = expf(BB[tid - 64]);
        __syncthreads();
    }
}
__device__ void phase_gla_scan(const Params& p, int vb, int nb) {
    bf16_t* DSS = (bf16_t*)(p.ws + WS_DSS); const float* DEC = (const float*)(p.ws + WS_DEC);
    for (int i = vb * NTHR + threadIdx.x; i < 2 * NB * 4 * 2048; i += nb * NTHR) {
        const int q = i & 2047, chain = i >> 11, dir = chain >> 5, b = (chain >> 2) & 7, h = chain & 3;
        const int d = (q & 15) * 4;
        float s0 = 0.f, s1 = 0.f, s2 = 0.f, s3 = 0.f;
        for (int st = 0; st < NCH; ++st) { const int n = dir ? NCH - 1 - st : st;
            bf16_t* ptr = DSS + dss_idx(dir, b, h, n) + (size_t)q * 4; const u32x2 w = *(const u32x2*)ptr;
            const f32x4 dc = *(const f32x4*)(DEC + dec_idx(dir, b, h, n) + d);
            u32x2 o; o.x = pk2(s0, s1); o.y = pk2(s2, s3); *(u32x2*)ptr = o;
            s0 = dc.x * s0 + __uint_as_float(w.x << 16); s1 = dc.y * s1 + __uint_as_float(w.x & 0xffff0000u);
            s2 = dc.z * s2 + __uint_as_float(w.y << 16); s3 = dc.w * s3 + __uint_as_float(w.y & 0xffff0000u); }
    }
}
__device__ void phase_gla_out(const Params& p, unsigned char* lds, int vb, int nb) {
    const bf16_t* PN = (const bf16_t*)(p.ws + WS_PN); const bf16_t* VT = (const bf16_t*)(p.ws + WS_VT);
    const bf16_t* DSS = (const bf16_t*)(p.ws + WS_DSS); bf16_t* MIX = (bf16_t*)(p.ws + WS_MIX);
    float* BF = (float*)lds; float* BB = BF + 4096;
    float* QF = BB + 4096; float* QB = QF + 4096; float* KF = QB + 4096; float* KB = KF + 4096;
    bf16_t* V = (bf16_t*)(KB + 4096);
    bf16_t* SF = V + 8192; bf16_t* SB = SF + 8192;
    float* ZT = QF;
    static_assert((2 * 4096 + 4 * 4096) * 4 + 8192 * 2 * 3 <= LDS_BYTES, "gla_out lds");
    const int tid = threadIdx.x;
    for (int item = vb; item < NB * 4 * NCH; item += nb) {
        const int n = item % NCH, h = (item / NCH) & 3, b = item / (NCH * 4);
        gla_gates(p, PN, b, h, n, BF, BB, ZT);
        for (int i = tid; i < 4096; i += NTHR) { const int c = i >> 6, d = i & 63; const int R = gla_row(b, n, c);
            float q = 0.f, k = 0.f; if (R >= 0) { q = bf2f(PN[(size_t)R * PN_LD + C_QGL + h * 64 + d]); k = bf2f(PN[(size_t)R * PN_LD + C_KGL + h * 64 + d]); }
            const float bf = BF[i], bb = BB[i];
            QF[i] = q * expf(bf); QB[i] = q * expf(bb); KF[i] = k * expf(-bf); KB[i] = k * expf(-bb); }
        for (int i = tid; i < 8192; i += NTHR) { const int e = i >> 6, c = i & 63; const int R = gla_row(b, n, c);
            V[c * 128 + e] = R < 0 ? (bf16_t)0 : VT[(size_t)(512 + h * 128 + e) * VT_LD + R]; }
        for (int i = tid; i < 8192 / 8; i += NTHR) { *(u32x4*)(SF + i * 8) = *(const u32x4*)(DSS + dss_idx(0, b, h, n) + i * 8); *(u32x4*)(SB + i * 8) = *(const u32x4*)(DSS + dss_idx(1, b, h, n) + i * 8); }
        __syncthreads();
        float* A = BF;
        for (int j = 0; j < 8; ++j) { const int i = tid + j * NTHR, c = i >> 6, s = i & 63; const float* Q = s <= c ? QF : QB; const float* K = s <= c ? KF : KB; float a = 0.f;
            for (int d = 0; d < 64; ++d) a += Q[c * 64 + d] * K[s * 64 + d];
            A[c * 65 + s] = a; }
        __syncthreads();
        float acc[16];
        { const int e = tid & 127, cg = tid >> 7;
#pragma unroll
          for (int i = 0; i < 16; ++i) acc[i] = 0.f;
          for (int s = 0; s < 64; ++s) { const float vv = bf2f(V[s * 128 + e]);
#pragma unroll
              for (int i = 0; i < 16; ++i) acc[i] += A[(cg * 16 + i) * 65 + s] * vv; }
          for (int d = 0; d < 64; ++d) { const float sf = bf2f(SF[e * 64 + d]), sb = bf2f(SB[e * 64 + d]);
#pragma unroll
              for (int i = 0; i < 16; ++i) acc[i] += QF[(cg * 16 + i) * 64 + d] * sf + QB[(cg * 16 + i) * 64 + d] * sb; } }
        __syncthreads();
        float* O = QF;
        { const int e = tid & 127, cg = tid >> 7;
#pragma unroll
          for (int i = 0; i < 16; ++i) O[(cg * 16 + i) * 128 + e] = acc[i]; }
        __syncthreads();
        { const int c = tid >> 3, part = tid & 7; float v[16]; float ss = 0.f;
#pragma unroll
          for (int j = 0; j < 16; ++j) { v[j] = O[c * 128 + part * 16 + j]; ss += v[j] * v[j]; }
          ss += __shfl_xor(ss, 1); ss += __shfl_xor(ss, 2); ss += __shfl_xor(ss, 4);
          const float rstd = rsqrtf(ss * (1.f / 128.f) + EPS);
          const int R = gla_row(b, n, c);
          int Rout = R; if (n == 0) Rout = (c == 63) ? MR + b : -1;
          if (Rout >= 0) { unsigned w[8];
#pragma unroll
              for (int j = 0; j < 16; j += 2) { const int e = part * 16 + j;
                  const float g0 = bf2f(PN[(size_t)R * PN_LD + C_G + h * 128 + e]), g1 = bf2f(PN[(size_t)R * PN_LD + C_G + h * 128 + e + 1]);
                  w[j >> 1] = pk2(v[j] * rstd * p.gla_gain[e] * silu(g0), v[j + 1] * rstd * p.gla_gain[e + 1] * silu(g1)); }
              bf16_t* dst = MIX + (size_t)Rout * 1024 + 512 + h * 128 + part * 16;
              *(u32x4*)dst = (u32x4){w[0], w[1], w[2], w[3]}; *(u32x4*)(dst + 8) = (u32x4){w[4], w[5], w[6], w[7]}; } }
        __syncthreads();
    }
}

__device__ void phase_na(const Params& p, unsigned char* lds, int vb, int nb) {
    const bf16_t* PN = (const bf16_t*)(p.ws + WS_PN); const bf16_t* VT = (const bf16_t*)(p.ws + WS_VT); bf16_t* MIX = (bf16_t*)(p.ws + WS_MIX);
    const int tid = threadIdx.x, lane = tid & 63, h = tid >> 6;
    float* OB = (float*)lds + h * 4096;
    float* SS = (float*)lds + 8 * 4096;
    for (int item = vb; item < NB * 32 + 1; item += nb) {
        if (item == NB * 32) {
            const bf16_t* qp = PN + (size_t)(RMETA + 15) * PN_LD + C_QNA + h * 64; float s = -INFINITY;
            if (lane < 16) { const bf16_t* kp = PN + (size_t)(RMETA + lane) * PN_LD + C_KNA + h * 64; float a = 0.f; for (int d = 0; d < 64; ++d) a += bf2f(qp[d]) * bf2f(kp[d]); s = a; }
            const float mx = wave_max(s); const float pe = lane < 16 ? expf(s - mx) : 0.f; const float l = wave_sum(pe);
            float o = 0.f; for (int m = 0; m < 16; ++m) o += __shfl(pe, m) * bf2f(VT[(size_t)(h * 64 + lane) * VT_LD + RMETA + m]);
            o /= l; const float ssq = wave_sum(o * o);
            if (lane == 0) SS[h * 64] = ssq;
            __syncthreads();
            float tot = 0.f; for (int w = 0; w < 8; ++w) tot += SS[w * 64];
            const float rstd = rsqrtf(tot * (1.f / 512.f) + EPS); const bf16_t val = (bf16_t)f2bf(o * rstd * p.na_gain[h * 64 + lane]);
            for (int b = 0; b < NB; ++b) MIX[(size_t)(MR + b) * 1024 + h * 64 + lane] = val;
            __syncthreads();
            continue;
        }
        const int b = item >> 5, r = item & 31; const int rs = min(max(r - 4, 0), 24);
        for (int c = 0; c < 64; ++c) {
            const int R = b * SEQ + r * 64 + c; const int cs = min(max(c - 8, 0), 48);
            const bf16_t* qp = PN + (size_t)R * PN_LD + C_QNA + h * 64;
            float sc[3]; int kR[3];
#pragma unroll
            for (int j = 0; j < 3; ++j) { const int nk = lane + 64 * j; sc[j] = -INFINITY; kR[j] = 0;
                if (nk < 144) { float bias = 0.f; int Rk;
                    if (nk < 128) { const int i = nk >> 4, jj = nk & 15; const int kr = rs + i, kc = cs + jj; Rk = b * SEQ + kr * 64 + kc; bias = p.rpb[(h * 15 + (kr - r + 7)) * 31 + (kc - c + 15)]; }
                    else Rk = RMETA + (nk - 128);
                    const bf16_t* kp = PN + (size_t)Rk * PN_LD + C_KNA + h * 64; float a = 0.f;
                    for (int d = 0; d < 64; d += 8) { const u32x4 qw = *(const u32x4*)(qp + d), kw = *(const u32x4*)(kp + d);
                        a += __uint_as_float(qw.x << 16) * __uint_as_float(kw.x << 16) + __uint_as_float(qw.x & 0xffff0000u) * __uint_as_float(kw.x & 0xffff0000u)
                           + __uint_as_float(qw.y << 16) * __uint_as_float(kw.y << 16) + __uint_as_float(qw.y & 0xffff0000u) * __uint_as_float(kw.y & 0xffff0000u)
                           + __uint_as_float(qw.z << 16) * __uint_as_float(kw.z << 16) + __uint_as_float(qw.z & 0xffff0000u) * __uint_as_float(kw.z & 0xffff0000u)
                           + __uint_as_float(qw.w << 16) * __uint_as_float(kw.w << 16) + __uint_as_float(qw.w & 0xffff0000u) * __uint_as_float(kw.w & 0xffff0000u); }
                    sc[j] = a + bias; kR[j] = Rk; } }
            const float mx = wave_max(fmaxf(fmaxf(sc[0], sc[1]), sc[2]));
            float pe[3]; float ls = 0.f;
#pragma unroll
            for (int j = 0; j < 3; ++j) { pe[j] = (lane + 64 * j < 144) ? expf(sc[j] - mx) : 0.f; ls += pe[j]; }
            const float l = wave_sum(ls);
            float o = 0.f; const bf16_t* vrow = VT + (size_t)(h * 64 + lane) * VT_LD;
            for (int nk = 0; nk < 144; ++nk) { const int j = nk >> 6, sl = nk & 63;
                const float pp = __shfl(j == 0 ? pe[0] : (j == 1 ? pe[1] : pe[2]), sl); const int Rk = __shfl(j == 0 ? kR[0] : (j == 1 ? kR[1] : kR[2]), sl);
                o += pp * bf2f(vrow[Rk]); }
            o /= l;
            OB[c * 64 + lane] = o;
            const float ssq = wave_sum(o * o);
            if (lane == 0) SS[h * 64 + c] = ssq;
        }
        __syncthreads();
        for (int c = 0; c < 64; ++c) { float tot = 0.f;
#pragma unroll
            for (int w = 0; w < 8; ++w) tot += SS[w * 64 + c];
            const float rstd = rsqrtf(tot * (1.f / 512.f) + EPS);
            MIX[(size_t)(b * SEQ + r * 64 + c) * 1024 + h * 64 + lane] = (bf16_t)f2bf(OB[c * 64 + lane] * rstd * p.na_gain[h * 64 + lane]); }
        __syncthreads();
    }
}

__device__ void phase_rows1(const Params& p, int vb, int nb) {
    const float* Y = (const float*)(p.ws + WS_Y); bf16_t* AIN = (bf16_t*)(p.ws + WS_U);
    const int lane = threadIdx.x & 63, gw = vb * NWAVE + (threadIdx.x >> 6), NGW = nb * NWAVE;
    for (int R = gw; R < MX; R += NGW) {
        const float* base = R < MR ? p.x + (size_t)R * DM : p.meta + (size_t)15 * DM; const float* y = Y + (size_t)R * DM;
        f32x4 v[4]; float s = 0.f;
#pragma unroll
        for (int j = 0; j < 4; ++j) { v[j] = *(const f32x4*)(y + 256 * j + 4 * lane); s += v[j].x * v[j].x + v[j].y * v[j].y + v[j].z * v[j].z + v[j].w * v[j].w; }
        const float rstd = rsqrtf(wave_sum(s) * (1.f / DM) + EPS); float s2 = 0.f;
#pragma unroll
        for (int j = 0; j < 4; ++j) { const f32x4 g = *(const f32x4*)(p.g_post + 256 * j + 4 * lane); const f32x4 bs = *(const f32x4*)(base + 256 * j + 4 * lane);
            v[j].x = bs.x + v[j].x * rstd * g.x; v[j].y = bs.y + v[j].y * rstd * g.y; v[j].z = bs.z + v[j].z * rstd * g.z; v[j].w = bs.w + v[j].w * rstd * g.w;
            s2 += v[j].x * v[j].x + v[j].y * v[j].y + v[j].z * v[j].z + v[j].w * v[j].w;
            if (R < MR) *(f32x4*)(p.out + (size_t)R * DM + 256 * j + 4 * lane) = v[j]; }
        const float rstd2 = rsqrtf(wave_sum(s2) * (1.f / DM) + EPS);
#pragma unroll
        for (int j = 0; j < 4; ++j) { const f32x4 g = *(const f32x4*)(p.g_ffn_pre + 256 * j + 4 * lane);
            u32x2 o; o.x = pk2(v[j].x * rstd2 * g.x, v[j].y * rstd2 * g.y); o.y = pk2(v[j].z * rstd2 * g.z, v[j].w * rstd2 * g.w);
            *(u32x2*)(AIN + (size_t)R * DM + 256 * j + 4 * lane) = o; }
    }
}
__device__ void phase_rows2(const Params& p, int vb, int nb) {
    const float* Y = (const float*)(p.ws + WS_Y);
    const int lane = threadIdx.x & 63, gw = vb * NWAVE + (threadIdx.x >> 6), NGW = nb * NWAVE;
    for (int R = gw; R < MR; R += NGW) {
        const float* y = Y + (size_t)R * DM; float* o = p.out + (size_t)R * DM;
        f32x4 v[4]; float s = 0.f;
#pragma unroll
        for (int j = 0; j < 4; ++j) { v[j] = *(const f32x4*)(y + 256 * j + 4 * lane); s += v[j].x * v[j].x + v[j].y * v[j].y + v[j].z * v[j].z + v[j].w * v[j].w; }
        const float rstd = rsqrtf(wave_sum(s) * (1.f / DM) + EPS);
#pragma unroll
        for (int j = 0; j < 4; ++j) { const f32x4 g = *(const f32x4*)(p.g_ffn_post + 256 * j + 4 * lane); f32x4 bs = *(const f32x4*)(o + 256 * j + 4 * lane);
            bs.x += v[j].x * rstd * g.x; bs.y += v[j].y * rstd * g.y; bs.z += v[j].z * rstd * g.z; bs.w += v[j].w * rstd * g.w; *(f32x4*)(o + 256 * j + 4 * lane) = bs; }
    }
}
__device__ void phase_act(const Params& p, int hf, int vb, int nb) {
    const bf16_t* AR = (const bf16_t*)(p.ws + WS_ARAW); bf16_t* ACT = (bf16_t*)(p.ws + WS_ACT);
    constexpr int G = FH / 8;
    for (int i = vb * NTHR + threadIdx.x; i < MR * G; i += nb * NTHR) {
        const int R = i / G, j0 = (i % G) * 8, b = R >> 11, t = R & 2047;
        const int Rm = t > 0 ? R - 1 : MR + b; const bool hasp = t < SEQ - 1;
        const u32x4 z4 = (u32x4){0u, 0u, 0u, 0u};
        const u32x4 v0 = *(const u32x4*)(AR + (size_t)Rm * 2816 + j0), v1 = *(const u32x4*)(AR + (size_t)R * 2816 + j0), v2 = hasp ? *(const u32x4*)(AR + (size_t)(R + 1) * 2816 + j0) : z4;
        const u32x4 g0 = *(const u32x4*)(AR + (size_t)Rm * 2816 + FH + j0), g1 = *(const u32x4*)(AR + (size_t)R * 2816 + FH + j0), g2 = hasp ? *(const u32x4*)(AR + (size_t)(R + 1) * 2816 + FH + j0) : z4;
        unsigned ow[4];
#pragma unroll
        for (int q = 0; q < 4; ++q) { float res[2];
#pragma unroll
            for (int hh = 0; hh < 2; ++hh) { const int ch = hf * FH + j0 + 2 * q + hh;
                const float a0 = hh ? __uint_as_float(v0[q] & 0xffff0000u) : __uint_as_float(v0[q] << 16), a1 = hh ? __uint_as_float(v1[q] & 0xffff0000u) : __uint_as_float(v1[q] << 16), a2 = hh ? __uint_as_float(v2[q] & 0xffff0000u) : __uint_as_float(v2[q] << 16);
                const float c0 = hh ? __uint_as_float(g0[q] & 0xffff0000u) : __uint_as_float(g0[q] << 16), c1 = hh ? __uint_as_float(g1[q] & 0xffff0000u) : __uint_as_float(g1[q] << 16), c2 = hh ? __uint_as_float(g2[q] & 0xffff0000u) : __uint_as_float(g2[q] << 16);
                const float cv = a0 * p.conv_w[ch] + a1 * p.conv_w[2 * DFF + ch] + a2 * p.conv_w[4 * DFF + ch] + p.conv_b[ch];
                const float cg = c0 * p.conv_w[DFF + ch] + c1 * p.conv_w[3 * DFF + ch] + c2 * p.conv_w[5 * DFF + ch] + p.conv_b[DFF + ch];
                res[hh] = gelu_tanh(cg) * cv; }
            ow[q] = pk2(res[0], res[1]); }
        *(u32x4*)(ACT + (size_t)R * DFF + hf * FH + j0) = (u32x4){ow[0], ow[1], ow[2], ow[3]};
    }
}

enum { PH_PREP = 0, PH_GEMM1, PH_GLA_DS, PH_NA_SCAN, PH_GLA_OUT, PH_WO, PH_ROWS1, PH_F1A, PH_ACTA, PH_F1B, PH_ACTB, PH_F2, PH_ROWS2, PH_COUNT };

__global__ void __launch_bounds__(NTHR, 2) fwd_kernel(Params p) {
    extern __shared__ __attribute__((aligned(16))) unsigned char lds[];
    const int vb = blockIdx.x, nb = gridDim.x;
    unsigned char* ws = p.ws;
    switch (p.phase) {
    case PH_PREP: phase_prep(p, lds, vb, nb); break;
    case PH_GEMM1: { EpiPN e{(bf16_t*)(ws + WS_PN), (bf16_t*)(ws + WS_VT)};
        gemm_valu((const bf16_t*)(ws + WS_U), DM, (const bf16_t*)(ws + WS_WTN), DM, MR + NMETA, PN_VALID, DM, e, lds, vb, nb);
        EpiVT ev{(bf16_t*)(ws + WS_VT)};
        gemm_valu((const bf16_t*)(ws + WS_U), DM, (const bf16_t*)(ws + WS_WTV), DM, MR + NMETA, 1024, DM, ev, lds, vb, nb); } break;
    case PH_GLA_DS: phase_gla_ds(p, lds, vb, nb); break;
    case PH_NA_SCAN: phase_gla_scan(p, vb, nb); phase_na(p, lds, vb, nb); break;
    case PH_GLA_OUT: phase_gla_out(p, lds, vb, nb); break;
    case PH_WO: { EpiF32S e{(float*)(ws + WS_Y), DM}; gemm_valu((const bf16_t*)(ws + WS_MIX), 1024, (const bf16_t*)(ws + WS_WTO), 1024, MX, DM, 1024, e, lds, vb, nb); } break;
    case PH_ROWS1: phase_rows1(p, vb, nb); break;
    case PH_F1A: case PH_F1B: { const int hf = p.phase == PH_F1B; EpiBF e{(bf16_t*)(ws + WS_ARAW), 2816};
        gemm_valu((const bf16_t*)(ws + WS_U), DM, (const bf16_t*)(ws + WS_WF1) + (size_t)hf * 2816 * 1024, DM, MX, 2816, DM, e, lds, vb, nb); } break;
    case PH_ACTA: case PH_ACTB: phase_act(p, p.phase == PH_ACTB, vb, nb); break;
    case PH_F2: { EpiF32S e{(float*)(ws + WS_Y), DM}; gemm_valu((const bf16_t*)(ws + WS_ACT), DFF, (const bf16_t*)(ws + WS_WF2), DFF, MR, DM, DFF, e, lds, vb, nb); } break;
    case PH_ROWS2: phase_rows2(p, vb, nb); break;
    default: break;
    }
}

extern "C" void kernel_launch(void* const* d_in, const int* in_sizes, int n_in, void* d_out, int out_size, void* d_ws, size_t ws_size, hipStream_t stream) {
    static int ok = 0;
    if (ok == 0) {
        if (n_in != 19 || out_size != MR * DM || ws_size < 256 * MiB) { fprintf(stderr, "kernel_launch: unexpected shapes n_in %d out %d ws %zu\n", n_in, out_size, ws_size); ok = -1; return; }
        if (hipFuncSetAttribute((const void*)fwd_kernel, hipFuncAttributeMaxDynamicSharedMemorySize, LDS_BYTES) != hipSuccess) { fprintf(stderr, "hipFuncSetAttribute failed\n"); ok = -1; return; }
        ok = 1;
    }
    if (ok < 0) return;
    Params p{};
    p.x = (const float*)d_in[0]; p.meta = (const float*)d_in[1]; p.g_pre = (const float*)d_in[2]; p.w_in = (const float*)d_in[3]; p.rpb = (const float*)d_in[4]; p.na_gain = (const float*)d_in[5];
    p.up_f = (const float*)d_in[6]; p.bias_f = (const float*)d_in[7]; p.up_b = (const float*)d_in[8]; p.bias_b = (const float*)d_in[9]; p.gla_gain = (const float*)d_in[10]; p.w_o = (const float*)d_in[11];
    p.g_post = (const float*)d_in[12]; p.g_ffn_pre = (const float*)d_in[13]; p.w_f1 = (const float*)d_in[14]; p.conv_w = (const float*)d_in[15]; p.conv_b = (const float*)d_in[16]; p.w_f2 = (const float*)d_in[17]; p.g_ffn_post = (const float*)d_in[18];
    p.out = (float*)d_out; p.ws = (unsigned char*)d_ws;
    for (int ph = 0; ph < PH_COUNT; ++ph) { p.phase = ph; hipLaunchKernelGGL(fwd_kernel, dim3(1024), dim3(NTHR), LDS_BYTES, stream, p); }
}
```

```cpp
#include <hip/hip_runtime.h>
#include <cstdint>
#include <cstdio>

typedef unsigned short bf16_t;
typedef float f32x4 __attribute__((ext_vector_type(4)));
typedef unsigned u32x4 __attribute__((ext_vector_type(4)));
typedef unsigned u32x2 __attribute__((ext_vector_type(2)));

constexpr int NB = 8, SEQ = 2048, DM = 1024, NMETA = 16;
constexpr int MR = NB * SEQ;
constexpr int MROWS = 16640;
constexpr int RMETA = MR;
constexpr int PN_LD = 2304;
constexpr int C_QNA = 0, C_KNA = 512, C_QGL = 1024, C_KGL = 1280, C_G = 1536, C_Z = 2048, PN_VALID = 2080;
constexpr int VT_LD = MROWS;
constexpr int INC = 3104, DFF = 2816, FH = 1408;
constexpr int NCH = 33;
constexpr float EPS = 1e-6f;
constexpr int MX = MR + 8;

constexpr size_t MiB = 1u << 20;
constexpr size_t WS_CTL = 0;
constexpr size_t WS_WTN = 1 * MiB;
constexpr size_t WS_WTV = WS_WTN + (size_t)2304 * 1024 * 2;
constexpr size_t WS_WTO = WS_WTV + (size_t)1024 * 1024 * 2;
constexpr size_t WS_WF1 = WS_WTO + (size_t)1024 * 1024 * 2;
constexpr size_t WS_WF2 = WS_WF1 + (size_t)5632 * 1024 * 2;
constexpr size_t WS_DEC = 27 * MiB;
constexpr size_t WS_U   = 30 * MiB;
constexpr size_t WS_PN  = 63 * MiB;
constexpr size_t WS_VT  = 137 * MiB;
constexpr size_t WS_MIX = 170 * MiB;
constexpr size_t WS_DSS = 203 * MiB;
constexpr size_t WS_END = 236 * MiB;
constexpr size_t WS_Y   = 63 * MiB;
constexpr size_t WS_ARAW = 63 * MiB;
constexpr size_t WS_ACT = 152 * MiB;
static_assert(WS_WF2 + (size_t)1024 * 2816 * 2 <= WS_DEC, "weights");
static_assert(WS_ARAW + (size_t)MX * 2816 * 2 <= WS_ACT, "araw");
static_assert(WS_ACT + (size_t)MR * 2816 * 2 <= 256 * MiB, "act");
static_assert(WS_MIX + (size_t)MX * 1024 * 2 <= WS_DSS, "mix");

constexpr int NTHR = 512, NWAVE = 8;
constexpr int PH_LDS = 147456;
constexpr int LDS_BYTES = PH_LDS + 1024;

struct Params {
    const float* x; const float* meta; const float* g_pre; const float* w_in; const float* rpb; const float* na_gain;
    const float* up_f; const float* bias_f; const float* up_b; const float* bias_b; const float* gla_gain; const float* w_o;
    const float* g_post; const float* g_ffn_pre; const float* w_f1; const float* conv_w; const float* conv_b; const float* w_f2; const float* g_ffn_post;
    float* out; unsigned char* ws; int ph_lo; int ph_hi;
};

__device__ __forceinline__ float bf2f(bf16_t v) { return __uint_as_float(((unsigned)v) << 16); }
__device__ __forceinline__ unsigned f2bf(float f) { unsigned u = __float_as_uint(f); return (u + 0x7fffu + ((u >> 16) & 1u)) >> 16; }
__device__ __forceinline__ unsigned pk2(float lo, float hi) { return f2bf(lo) | (f2bf(hi) << 16); }
__device__ __forceinline__ float wave_sum(float v) {
#pragma unroll
    for (int o = 1; o < 64; o <<= 1) v += __shfl_xor(v, o);
    return v;
}
__device__ __forceinline__ float wave_max(float v) {
#pragma unroll
    for (int o = 1; o < 64; o <<= 1) v = fmaxf(v, __shfl_xor(v, o));
    return v;
}
__device__ __forceinline__ float log_sigmoid(float x) { return fminf(x, 0.f) - log1pf(expf(-fabsf(x))); }
__device__ __forceinline__ float silu(float x) { return x / (1.f + expf(-x)); }
__device__ __forceinline__ float gelu_tanh(float x) { const float u = 0.7978845608028654f * (x + 0.044715f * x * x * x); return x / (1.f + expf(-2.f * u)); }

__device__ __forceinline__ void transpose_item(const float* W, int ldw, int src_n0, int k0, bf16_t* WT, int K, int dst_row0, float scale, float* scr, int lane) {
#pragma unroll 8
    for (int i = 0; i < 32; ++i) { const int kk = 2 * i + (lane >> 5); scr[kk * 33 + (lane & 31)] = W[(size_t)(k0 + kk) * ldw + src_n0 + (lane & 31)] * scale; }
    __builtin_amdgcn_s_waitcnt(0xc07f); asm volatile("" ::: "memory");
    const int c = lane & 7;
#pragma unroll
    for (int j = 0; j < 4; ++j) { const int n = (lane >> 3) + 8 * j; const float* s = scr + (8 * c) * 33 + n;
        u32x4 o; o.x = pk2(s[0 * 33], s[1 * 33]); o.y = pk2(s[2 * 33], s[3 * 33]); o.z = pk2(s[4 * 33], s[5 * 33]); o.w = pk2(s[6 * 33], s[7 * 33]);
        *(u32x4*)(WT + (size_t)(dst_row0 + n) * K + k0 + 8 * c) = o; }
    __builtin_amdgcn_s_waitcnt(0xc07f); asm volatile("" ::: "memory");
}
__device__ __forceinline__ int wtn_src(int n, float& sc) {
    sc = 1.f;
    if (n < 512) { sc = 0.125f; return n; }
    if (n < 1024) return n;
    if (n < 1280) { sc = 0.125f; return 1536 + (n - 1024); }
    if (n < 1536) return 1792 + (n - 1280);
    if (n < 2048) return 2560 + (n - 1536);
    return 3072 + (n - 2048);
}
__device__ __forceinline__ int wtv_src(int n) { return n < 512 ? 1024 + n : 2048 + (n - 512); }
__device__ __forceinline__ int wf1_src(int n) { const int hf = n / 2816, w = n % 2816; return w < FH ? hf * FH + w : 2816 + hf * FH + (w - FH); }

__device__ __forceinline__ void phase_prep(const Params& p, unsigned char* lds, int vb, int nb) {
    const int tid = threadIdx.x, lane = tid & 63, wave = tid >> 6;
    float* scr = (float*)lds + wave * (64 * 33);
    bf16_t* WTN = (bf16_t*)(p.ws + WS_WTN); bf16_t* WTV = (bf16_t*)(p.ws + WS_WTV); bf16_t* WTO = (bf16_t*)(p.ws + WS_WTO);
    bf16_t* WF1 = (bf16_t*)(p.ws + WS_WF1); bf16_t* WF2 = (bf16_t*)(p.ws + WS_WF2); bf16_t* U = (bf16_t*)(p.ws + WS_U);
    const int gw = vb * NWAVE + wave, NGW = nb * NWAVE;
    constexpr int I_N = (2080 / 32) * 16, I_V = (1024 / 32) * 16, I_O = (1024 / 32) * 16, I_F1 = (5632 / 32) * 16, I_F2 = (1024 / 32) * 44;
    constexpr int NIT = I_N + I_V + I_O + I_F1 + I_F2;
    for (int it = gw; it < NIT; it += NGW) {
        int r = it;
        if (r < I_N) { const int nb32 = r / 16, kb = r % 16; float sc; const int src = wtn_src(nb32 * 32, sc); transpose_item(p.w_in, INC, src, kb * 64, WTN, 1024, nb32 * 32, sc, scr, lane); continue; } r -= I_N;
        if (r < I_V) { const int nb32 = r / 16, kb = r % 16; transpose_item(p.w_in, INC, wtv_src(nb32 * 32), kb * 64, WTV, 1024, nb32 * 32, 1.f, scr, lane); continue; } r -= I_V;
        if (r < I_O) { const int nb32 = r / 16, kb = r % 16; transpose_item(p.w_o, 1024, nb32 * 32, kb * 64, WTO, 1024, nb32 * 32, 1.f, scr, lane); continue; } r -= I_O;
        if (r < I_F1) { const int nb32 = r / 16, kb = r % 16; transpose_item(p.w_f1, 2 * DFF, wf1_src(nb32 * 32), kb * 64, WF1, 1024, nb32 * 32, 1.f, scr, lane); continue; } r -= I_F1;
        { const int nb32 = r / 44, kb = r % 44; transpose_item(p.w_f2, 1024, nb32 * 32, kb * 64, WF2, DFF, nb32 * 32, 1.f, scr, lane); }
    }
    for (int i = vb * NTHR + tid; i < (2304 - 2080) * 1024 / 8; i += nb * NTHR) *(u32x4*)(WTN + (size_t)2080 * 1024 + (size_t)i * 8) = (u32x4){0u, 0u, 0u, 0u};
    for (int R = gw; R < MR + NMETA; R += NGW) {
        const float* src = R < MR ? p.x + (size_t)R * DM : p.meta + (size_t)(R - MR) * DM;
        f32x4 v[4]; float s = 0.f;
#pragma unroll
        for (int j = 0; j < 4; ++j) { v[j] = *(const f32x4*)(src + 256 * j + 4 * lane); s += v[j].x * v[j].x + v[j].y * v[j].y + v[j].z * v[j].z + v[j].w * v[j].w; }
        const float rstd = rsqrtf(wave_sum(s) * (1.f / DM) + EPS);
#pragma unroll
        for (int j = 0; j < 4; ++j) { const f32x4 g = *(const f32x4*)(p.g_pre + 256 * j + 4 * lane);
            u32x2 o; o.x = pk2(v[j].x * rstd * g.x, v[j].y * rstd * g.y); o.y = pk2(v[j].z * rstd * g.z, v[j].w * rstd * g.w);
            *(u32x2*)(U + (size_t)R * DM + 256 * j + 4 * lane) = o; }
    }
}

template <class Epi>
__device__ __forceinline__ void gemm_valu(const bf16_t* A, int lda, const bf16_t* Bt, int ldb, int M, int N, int K, const Epi& epi, unsigned char* lds, int vb, int nb) {
    float* As = (float*)lds;
    float* Bs = As + 32 * 65;
    const int tid = threadIdx.x, ty = tid >> 4, tx = tid & 15;
    const int tm = (M + 63) / 64, tn = (N + 63) / 64;
    const int lrow = tid >> 3, lk = (tid & 7) * 4;
    for (int tile = vb; tile < tm * tn; tile += nb) {
        const int m0 = (tile / tn) * 64, n0 = (tile % tn) * 64;
        float acc[2][4] = {{0.f, 0.f, 0.f, 0.f}, {0.f, 0.f, 0.f, 0.f}};
        for (int k0 = 0; k0 < K; k0 += 32) {
            { const int m = m0 + lrow; u32x2 w = (u32x2){0u, 0u}; if (m < M) w = *(const u32x2*)(A + (size_t)m * lda + k0 + lk);
              As[(lk + 0) * 65 + lrow] = __uint_as_float(w.x << 16); As[(lk + 1) * 65 + lrow] = __uint_as_float(w.x & 0xffff0000u);
              As[(lk + 2) * 65 + lrow] = __uint_as_float(w.y << 16); As[(lk + 3) * 65 + lrow] = __uint_as_float(w.y & 0xffff0000u); }
            { const int n = n0 + lrow; u32x2 w = (u32x2){0u, 0u}; if (n < N) w = *(const u32x2*)(Bt + (size_t)n * ldb + k0 + lk);
              Bs[(lk + 0) * 65 + lrow] = __uint_as_float(w.x << 16); Bs[(lk + 1) * 65 + lrow] = __uint_as_float(w.x & 0xffff0000u);
              Bs[(lk + 2) * 65 + lrow] = __uint_as_float(w.y << 16); Bs[(lk + 3) * 65 + lrow] = __uint_as_float(w.y & 0xffff0000u); }
            __syncthreads();
#pragma unroll 8
            for (int k = 0; k < 32; ++k) {
                const float a0 = As[k * 65 + ty * 2], a1 = As[k * 65 + ty * 2 + 1];
                const float b0 = Bs[k * 65 + tx * 4], b1 = Bs[k * 65 + tx * 4 + 1], b2 = Bs[k * 65 + tx * 4 + 2], b3 = Bs[k * 65 + tx * 4 + 3];
                acc[0][0] += a0 * b0; acc[0][1] += a0 * b1; acc[0][2] += a0 * b2; acc[0][3] += a0 * b3;
                acc[1][0] += a1 * b0; acc[1][1] += a1 * b1; acc[1][2] += a1 * b2; acc[1][3] += a1 * b3;
            }
            __syncthreads();
        }
#pragma unroll
        for (int i = 0; i < 2; ++i)
#pragma unroll
            for (int j = 0; j < 4; ++j) { const int m = m0 + ty * 2 + i, n = n0 + tx * 4 + j; if (m < M && n < N) epi(m, n, acc[i][j]); }
    }
}
struct EpiPN { bf16_t* PN; bf16_t* VT; __device__ void operator()(int m, int n, float v) const { if (n < PN_VALID) PN[(size_t)m * PN_LD + n] = (bf16_t)f2bf(v); else VT[(size_t)(n - PN_VALID) * VT_LD + m] = (bf16_t)f2bf(v); } };
struct EpiVT { bf16_t* VT; __device__ void operator()(int m, int n, float v) const { VT[(size_t)n * VT_LD + m] = (bf16_t)f2bf(v); } };
struct EpiF32S { float* C; int ldc; __device__ void operator()(int m, int n, float v) const { C[(size_t)m * ldc + n] = v; } };
struct EpiBF { bf16_t* C; int ldc; __device__ void operator()(int m, int n, float v) const { C[(size_t)m * ldc + n] = (bf16_t)f2bf(v); } };

__device__ __forceinline__ int gla_row(int b, int n, int c) { if (n == 0) return c < 48 ? -1 : RMETA + (c - 48); return b * SEQ + (n - 1) * 64 + c; }
__device__ __forceinline__ void gla_gates(const Params& p, const bf16_t* PN, int b, int h, int n, float* BF, float* BB, float* ZT  ) {
    const int tid = threadIdx.x;
    for (int i = tid; i < 64 * 32; i += NTHR) { const int c = i >> 5, r = i & 31; const int R = gla_row(b, n, c); ZT[i] = R < 0 ? 0.f : bf2f(PN[(size_t)R * PN_LD + C_Z + r]); }
    __syncthreads();
    for (int i = tid; i < 2 * 64 * 64; i += NTHR) {
        const int dir = i >> 12, c = (i >> 6) & 63, d = i & 63; const int col = h * 64 + d;
        const float* up = dir ? p.up_b : p.up_f; float a = dir ? p.bias_b[col] : p.bias_f[col];
#pragma unroll
        for (int r = 0; r < 16; ++r) a += ZT[c * 32 + dir * 16 + r] * up[r * 256 + col];
        float la = log_sigmoid(a) * (1.f / 16.f);
        if (gla_row(b, n, c) < 0) la = 0.f;
        (dir ? BB : BF)[c * 64 + d] = la;
    }
    __syncthreads();
    if (tid < 64) { float s = 0.f; for (int c = 0; c < 64; ++c) { s += BF[c * 64 + tid]; BF[c * 64 + tid] = s; } }
    else if (tid < 128) { const int d = tid - 64; float s = 0.f; for (int c = 63; c >= 0; --c) { s += BB[c * 64 + d]; BB[c * 64 + d] = s; } }
    __syncthreads();
}
__device__ __forceinline__ size_t dss_idx(int dir, int b, int h, int n) { return ((((size_t)dir * NB + b) * 4 + h) * NCH + n) * 8192; }
__device__ __forceinline__ size_t dec_idx(int dir, int b, int h, int n) { return ((((size_t)dir * NB + b) * 4 + h) * NCH + n) * 64; }

__device__ __forceinline__ void phase_gla_ds(const Params& p, unsigned char* lds, int vb, int nb) {
    const bf16_t* PN = (const bf16_t*)(p.ws + WS_PN); const bf16_t* VT = (const bf16_t*)(p.ws + WS_VT);
    bf16_t* DSS = (bf16_t*)(p.ws + WS_DSS); float* DEC = (float*)(p.ws + WS_DEC);
    float* BF = (float*)lds; float* BB = BF + 4096; float* KF = BB + 4096; float* KB = KF + 4096; float* V = KB + 4096; float* ZT = V + 8192;
    const int tid = threadIdx.x;
    for (int item = vb; item < NB * 4 * NCH; item += nb) {
        const int n = item % NCH, h = (item / NCH) & 3, b = item / (NCH * 4);
        gla_gates(p, PN, b, h, n, BF, BB, ZT);
        for (int i = tid; i < 4096; i += NTHR) { const int c = i >> 6, d = i & 63; const int R = gla_row(b, n, c);
            const float k = R < 0 ? 0.f : bf2f(PN[(size_t)R * PN_LD + C_KGL + h * 64 + d]);
            KF[i] = k * expf(BF[63 * 64 + d] - BF[i]); KB[i] = k * expf(BB[d] - BB[i]); }
        for (int i = tid; i < 8192; i += NTHR) { const int e = i >> 6, c = i & 63; const int R = gla_row(b, n, c);
            V[c * 128 + e] = R < 0 ? 0.f : bf2f(VT[(size_t)(512 + h * 128 + e) * VT_LD + R]); }
        __syncthreads();
        { const int dir = tid >> 8, e = tid & 127, dh = (tid >> 7) & 1; const float* KE = dir ? KB : KF;
          float acc[32];
#pragma unroll
          for (int j = 0; j < 32; ++j) acc[j] = 0.f;
          for (int c = 0; c < 64; ++c) { const float vv = V[c * 128 + e];
#pragma unroll
              for (int j = 0; j < 32; ++j) acc[j] += KE[c * 64 + dh * 32 + j] * vv; }
          bf16_t* dst = DSS + dss_idx(dir, b, h, n) + e * 64 + dh * 32;
#pragma unroll
          for (int j = 0; j < 32; j += 8) { u32x4 o; o.x = pk2(acc[j], acc[j + 1]); o.y = pk2(acc[j + 2], acc[j + 3]); o.z = pk2(acc[j + 4], acc[j + 5]); o.w = pk2(acc[j + 6], acc[j + 7]); *(u32x4*)(dst + j) = o; } }
        if (tid < 64) DEC[dec_idx(0, b, h, n) + tid] = expf(BF[63 * 64 + tid]);
        else if (tid < 128) DEC[dec_idx(1, b, h, n) + tid - 64] = expf(BB[tid - 64]);
        __syncthreads();
    }
}
__device__ __forceinline__ void phase_gla_scan(const Params& p, int vb, int nb) {
    bf16_t* DSS = (bf16_t*)(p.ws + WS_DSS); const float* DEC = (const float*)(p.ws + WS_DEC);
    for (int i = vb * NTHR + threadIdx.x; i < 2 * NB * 4 * 2048; i += nb * NTHR) {
        const int q = i & 2047, chain = i >> 11, dir = chain >> 5, b = (chain >> 2) & 7, h = chain & 3;
        const int d = (q & 15) * 4;
        float s0 = 0.f, s1 = 0.f, s2 = 0.f, s3 = 0.f;
        for (int st = 0; st < NCH; ++st) { const int n = dir ? NCH - 1 - st : st;
            bf16_t* ptr = DSS + dss_idx(dir, b, h, n) + (size_t)q * 4; const u32x2 w = *(const u32x2*)ptr;
            const f32x4 dc = *(const f32x4*)(DEC + dec_idx(dir, b, h, n) + d);
            u32x2 o; o.x = pk2(s0, s1); o.y = pk2(s2, s3); *(u32x2*)ptr = o;
            s0 = dc.x * s0 + __uint_as_float(w.x << 16); s1 = dc.y * s1 + __uint_as_float(w.x & 0xffff0000u);
            s2 = dc.z * s2 + __uint_as_float(w.y << 16); s3 = dc.w * s3 + __uint_as_float(w.y & 0xffff0000u); }
    }
}
__device__ __forceinline__ void phase_gla_out(const Params& p, unsigned char* lds, int vb, int nb) {
    const bf16_t* PN = (const bf16_t*)(p.ws + WS_PN); const bf16_t* VT = (const bf16_t*)(p.ws + WS_VT);
    const bf16_t* DSS = (const bf16_t*)(p.ws + WS_DSS); bf16_t* MIX = (bf16_t*)(p.ws + WS_MIX);
    float* BF = (float*)lds; float* BB = BF + 4096;
    float* QF = BB + 4096; float* QB = QF + 4096; float* KF = QB + 4096; float* KB = KF + 4096;
    bf16_t* V = (bf16_t*)(KB + 4096);
    bf16_t* SF = V + 8192; bf16_t* SB = SF + 8192;
    float* ZT = QF;
    static_assert((2 * 4096 + 4 * 4096) * 4 + 8192 * 2 * 3 <= PH_LDS, "gla_out lds");
    const int tid = threadIdx.x;
    for (int item = vb; item < NB * 4 * NCH; item += nb) {
        const int n = item % NCH, h = (item / NCH) & 3, b = item / (NCH * 4);
        gla_gates(p, PN, b, h, n, BF, BB, ZT);
        for (int i = tid; i < 4096; i += NTHR) { const int c = i >> 6, d = i & 63; const int R = gla_row(b, n, c);
            float q = 0.f, k = 0.f; if (R >= 0) { q = bf2f(PN[(size_t)R * PN_LD + C_QGL + h * 64 + d]); k = bf2f(PN[(size_t)R * PN_LD + C_KGL + h * 64 + d]); }
            const float bf = BF[i], bb = BB[i];
            QF[i] = q * expf(bf); QB[i] = q * expf(bb); KF[i] = k * expf(-bf); KB[i] = k * expf(-bb); }
        for (int i = tid; i < 8192; i += NTHR) { const int e = i >> 6, c = i & 63; const int R = gla_row(b, n, c);
            V[c * 128 + e] = R < 0 ? (bf16_t)0 : VT[(size_t)(512 + h * 128 + e) * VT_LD + R]; }
        for (int i = tid; i < 8192 / 8; i += NTHR) { *(u32x4*)(SF + i * 8) = *(const u32x4*)(DSS + dss_idx(0, b, h, n) + i * 8); *(u32x4*)(SB + i * 8) = *(const u32x4*)(DSS + dss_idx(1, b, h, n) + i * 8); }
        __syncthreads();
        float* A = BF;
        for (int j = 0; j < 8; ++j) { const int i = tid + j * NTHR, c = i >> 6, s = i & 63; const float* Q = s <= c ? QF : QB; const float* K = s <= c ? KF : KB; float a = 0.f;
            for (int d = 0; d < 64; ++d) a += Q[c * 64 + d] * K[s * 64 + d];
            A[c * 65 + s] = a; }
        __syncthreads();
        float acc[16];
        { const int e = tid & 127, cg = tid >> 7;
#pragma unroll
          for (int i = 0; i < 16; ++i) acc[i] = 0.f;
          for (int s = 0; s < 64; ++s) { const float vv = bf2f(V[s * 128 + e]);
#pragma unroll
              for (int i = 0; i < 16; ++i) acc[i] += A[(cg * 16 + i) * 65 + s] * vv; }
          for (int d = 0; d < 64; ++d) { const float sf = bf2f(SF[e * 64 + d]), sb = bf2f(SB[e * 64 + d]);
#pragma unroll
              for (int i = 0; i < 16; ++i) acc[i] += QF[(cg * 16 + i) * 64 + d] * sf + QB[(cg * 16 + i) * 64 + d] * sb; } }
        __syncthreads();
        float* O = QF;
        { const int e = tid & 127, cg = tid >> 7;
#pragma unroll
          for (int i = 0; i < 16; ++i) O[(cg * 16 + i) * 128 + e] = acc[i]; }
        __syncthreads();
        { const int c = tid >> 3, part = tid & 7; float v[16]; float ss = 0.f;
#pragma unroll
          for (int j = 0; j < 16; ++j) { v[j] = O[c * 128 + part * 16 + j]; ss += v[j] * v[j]; }
          ss += __shfl_xor(ss, 1); ss += __shfl_xor(ss, 2); ss += __shfl_xor(ss, 4);
          const float rstd = rsqrtf(ss * (1.f / 128.f) + EPS);
          const int R = gla_row(b, n, c);
          int Rout = R; if (n == 0) Rout = (c == 63) ? MR + b : -1;
          if (Rout >= 0) { unsigned w[8];
#pragma unroll
              for (int j = 0; j < 16; j += 2) { const int e = part * 16 + j;
                  const float g0 = bf2f(PN[(size_t)R * PN_LD + C_G + h * 128 + e]), g1 = bf2f(PN[(size_t)R * PN_LD + C_G + h * 128 + e + 1]);
                  w[j >> 1] = pk2(v[j] * rstd * p.gla_gain[e] * silu(g0), v[j + 1] * rstd * p.gla_gain[e + 1] * silu(g1)); }
              bf16_t* dst = MIX + (size_t)Rout * 1024 + 512 + h * 128 + part * 16;
              *(u32x4*)dst = (u32x4){w[0], w[1], w[2], w[3]}; *(u32x4*)(dst + 8) = (u32x4){w[4], w[5], w[6], w[7]}; } }
        __syncthreads();
    }
}

__device__ __forceinline__ void phase_na(const Params& p, unsigned char* lds, int vb, int nb) {
    const bf16_t* PN = (const bf16_t*)(p.ws + WS_PN); const bf16_t* VT = (const bf16_t*)(p.ws + WS_VT); bf16_t* MIX = (bf16_t*)(p.ws + WS_MIX);
    const int tid = threadIdx.x, lane = tid & 63, h = tid >> 6;
    float* OB = (float*)lds + h * 4096;
    float* SS = (float*)lds + 8 * 4096;
    for (int item = vb; item < NB * 32 + 1; item += nb) {
        if (item == NB * 32) {
            const bf16_t* qp = PN + (size_t)(RMETA + 15) * PN_LD + C_QNA + h * 64; float s = -INFINITY;
            if (lane < 16) { const bf16_t* kp = PN + (size_t)(RMETA + lane) * PN_LD + C_KNA + h * 64; float a = 0.f; for (int d = 0; d < 64; ++d) a += bf2f(qp[d]) * bf2f(kp[d]); s = a; }
            const float mx = wave_max(s); const float pe = lane < 16 ? expf(s - mx) : 0.f; const float l = wave_sum(pe);
            float o = 0.f; for (int m = 0; m < 16; ++m) o += __shfl(pe, m) * bf2f(VT[(size_t)(h * 64 + lane) * VT_LD + RMETA + m]);
            o /= l; const float ssq = wave_sum(o * o);
            if (lane == 0) SS[h * 64] = ssq;
            __syncthreads();
            float tot = 0.f; for (int w = 0; w < 8; ++w) tot += SS[w * 64];
            const float rstd = rsqrtf(tot * (1.f / 512.f) + EPS); const bf16_t val = (bf16_t)f2bf(o * rstd * p.na_gain[h * 64 + lane]);
            for (int b = 0; b < NB; ++b) MIX[(size_t)(MR + b) * 1024 + h * 64 + lane] = val;
            __syncthreads();
            continue;
        }
        const int b = item >> 5, r = item & 31; const int rs = min(max(r - 4, 0), 24);
        for (int c = 0; c < 64; ++c) {
            const int R = b * SEQ + r * 64 + c; const int cs = min(max(c - 8, 0), 48);
            const bf16_t* qp = PN + (size_t)R * PN_LD + C_QNA + h * 64;
            float sc[3]; int kR[3];
#pragma unroll
            for (int j = 0; j < 3; ++j) { const int nk = lane + 64 * j; sc[j] = -INFINITY; kR[j] = 0;
                if (nk < 144) { float bias = 0.f; int Rk;
                    if (nk < 128) { const int i = nk >> 4, jj = nk & 15; const int kr = rs + i, kc = cs + jj; Rk = b * SEQ + kr * 64 + kc; bias = p.rpb[(h * 15 + (kr - r + 7)) * 31 + (kc - c + 15)]; }
                    else Rk = RMETA + (nk - 128);
                    const bf16_t* kp = PN + (size_t)Rk * PN_LD + C_KNA + h * 64; float a = 0.f;
                    for (int d = 0; d < 64; d += 8) { const u32x4 qw = *(const u32x4*)(qp + d), kw = *(const u32x4*)(kp + d);
                        a += __uint_as_float(qw.x << 16) * __uint_as_float(kw.x << 16) + __uint_as_float(qw.x & 0xffff0000u) * __uint_as_float(kw.x & 0xffff0000u)
                           + __uint_as_float(qw.y << 16) * __uint_as_float(kw.y << 16) + __uint_as_float(qw.y & 0xffff0000u) * __uint_as_float(kw.y & 0xffff0000u)
                           + __uint_as_float(qw.z << 16) * __uint_as_float(kw.z << 16) + __uint_as_float(qw.z & 0xffff0000u) * __uint_as_float(kw.z & 0xffff0000u)
                           + __uint_as_float(qw.w << 16) * __uint_as_float(kw.w << 16) + __uint_as_float(qw.w & 0xffff0000u) * __uint_as_float(kw.w & 0xffff0000u); }
                    sc[j] = a + bias; kR[j] = Rk; } }
            const float mx = wave_max(fmaxf(fmaxf(sc[0], sc[1]), sc[2]));
            float pe[3]; float ls = 0.f;
#pragma unroll
            for (int j = 0; j < 3; ++j) { pe[j] = (lane + 64 * j < 144) ? expf(sc[j] - mx) : 0.f; ls += pe[j]; }
            const float l = wave_sum(ls);
            float o = 0.f; const bf16_t* vrow = VT + (size_t)(h * 64 + lane) * VT_LD;
            for (int nk = 0; nk < 144; ++nk) { const int j = nk >> 6, sl = nk & 63;
                const float pp = __shfl(j == 0 ? pe[0] : (j == 1 ? pe[1] : pe[2]), sl); const int Rk = __shfl(j == 0 ? kR[0] : (j == 1 ? kR[1] : kR[2]), sl);
                o += pp * bf2f(vrow[Rk]); }
            o /= l;
            OB[c * 64 + lane] = o;
            const float ssq = wave_sum(o * o);
            if (lane == 0) SS[h * 64 + c] = ssq;
        }
        __syncthreads();
        for (int c = 0; c < 64; ++c) { float tot = 0.f;
#pragma unroll
            for (int w = 0; w < 8; ++w) tot += SS[w * 64 + c];
            const float rstd = rsqrtf(tot * (1.f / 512.f) + EPS);
            MIX[(size_t)(b * SEQ + r * 64 + c) * 1024 + h * 64 + lane] = (bf16_t)f2bf(OB[c * 64 + lane] * rstd * p.na_gain[h * 64 + lane]); }
        __syncthreads();
    }
}

__device__ __forceinline__ void phase_rows1(const Params& p, int vb, int nb) {
    const float* Y = (const float*)(p.ws + WS_Y); bf16_t* AIN = (bf16_t*)(p.ws + WS_U);
    const int lane = threadIdx.x & 63, gw = vb * NWAVE + (threadIdx.x >> 6), NGW = nb * NWAVE;
    for (int R = gw; R < MX; R += NGW) {
        const float* base = R < MR ? p.x + (size_t)R * DM : p.meta + (size_t)15 * DM; const float* y = Y + (size_t)R * DM;
        f32x4 v[4]; float s = 0.f;
#pragma unroll
        for (int j = 0; j < 4; ++j) { v[j] = *(const f32x4*)(y + 256 * j + 4 * lane); s += v[j].x * v[j].x + v[j].y * v[j].y + v[j].z * v[j].z + v[j].w * v[j].w; }
        const float rstd = rsqrtf(wave_sum(s) * (1.f / DM) + EPS); float s2 = 0.f;
#pragma unroll
        for (int j = 0; j < 4; ++j) { const f32x4 g = *(const f32x4*)(p.g_post + 256 * j + 4 * lane); const f32x4 bs = *(const f32x4*)(base + 256 * j + 4 * lane);
            v[j].x = bs.x + v[j].x * rstd * g.x; v[j].y = bs.y + v[j].y * rstd * g.y; v[j].z = bs.z + v[j].z * rstd * g.z; v[j].w = bs.w + v[j].w * rstd * g.w;
            s2 += v[j].x * v[j].x + v[j].y * v[j].y + v[j].z * v[j].z + v[j].w * v[j].w;
            if (R < MR) *(f32x4*)(p.out + (size_t)R * DM + 256 * j + 4 * lane) = v[j]; }
        const float rstd2 = rsqrtf(wave_sum(s2) * (1.f / DM) + EPS);
#pragma unroll
        for (int j = 0; j < 4; ++j) { const f32x4 g = *(const f32x4*)(p.g_ffn_pre + 256 * j + 4 * lane);
            u32x2 o; o.x = pk2(v[j].x * rstd2 * g.x, v[j].y * rstd2 * g.y); o.y = pk2(v[j].z * rstd2 * g.z, v[j].w * rstd2 * g.w);
            *(u32x2*)(AIN + (size_t)R * DM + 256 * j + 4 * lane) = o; }
    }
}
__device__ __forceinline__ void phase_rows2(const Params& p, int vb, int nb) {
    const float* Y = (const float*)(p.ws + WS_Y);
    const int lane = threadIdx.x & 63, gw = vb * NWAVE + (threadIdx.x >> 6), NGW = nb * NWAVE;
    for (int R = gw; R < MR; R += NGW) {
        const float* y = Y + (size_t)R * DM; float* o = p.out + (size_t)R * DM;
        f32x4 v[4]; float s = 0.f;
#pragma unroll
        for (int j = 0; j < 4; ++j) { v[j] = *(const f32x4*)(y + 256 * j + 4 * lane); s += v[j].x * v[j].x + v[j].y * v[j].y + v[j].z * v[j].z + v[j].w * v[j].w; }
        const float rstd = rsqrtf(wave_sum(s) * (1.f / DM) + EPS);
#pragma unroll
        for (int j = 0; j < 4; ++j) { const f32x4 g = *(const f32x4*)(p.g_ffn_post + 256 * j + 4 * lane); f32x4 bs = *(const f32x4*)(o + 256 * j + 4 * lane);
            bs.x += v[j].x * rstd * g.x; bs.y += v[j].y * rstd * g.y; bs.z += v[j].z * rstd * g.z; bs.w += v[j].w * rstd * g.w; *(f32x4*)(o + 256 * j + 4 * lane) = bs; }
    }
}
__device__ __forceinline__ void phase_act(const Params& p, int hf, int vb, int nb) {
    const bf16_t* AR = (const bf16_t*)(p.ws + WS_ARAW); bf16_t* ACT = (bf16_t*)(p.ws + WS_ACT);
    constexpr int G = FH / 8;
    for (int i = vb * NTHR + threadIdx.x; i < MR * G; i += nb * NTHR) {
        const int R = i / G, j0 = (i % G) * 8, b = R >> 11, t = R & 2047;
        const int Rm = t > 0 ? R - 1 : MR + b; const bool hasp = t < SEQ - 1;
        const u32x4 z4 = (u32x4){0u, 0u, 0u, 0u};
        const u32x4 v0 = *(const u32x4*)(AR + (size_t)Rm * 2816 + j0), v1 = *(const u32x4*)(AR + (size_t)R * 2816 + j0), v2 = hasp ? *(const u32x4*)(AR + (size_t)(R + 1) * 2816 + j0) : z4;
        const u32x4 g0 = *(const u32x4*)(AR + (size_t)Rm * 2816 + FH + j0), g1 = *(const u32x4*)(AR + (size_t)R * 2816 + FH + j0), g2 = hasp ? *(const u32x4*)(AR + (size_t)(R + 1) * 2816 + FH + j0) : z4;
        unsigned ow[4];
#pragma unroll
        for (int q = 0; q < 4; ++q) { float res[2];
#pragma unroll
            for (int hh = 0; hh < 2; ++hh) { const int ch = hf * FH + j0 + 2 * q + hh;
                const float a0 = hh ? __uint_as_float(v0[q] & 0xffff0000u) : __uint_as_float(v0[q] << 16), a1 = hh ? __uint_as_float(v1[q] & 0xffff0000u) : __uint_as_float(v1[q] << 16), a2 = hh ? __uint_as_float(v2[q] & 0xffff0000u) : __uint_as_float(v2[q] << 16);
                const float c0 = hh ? __uint_as_float(g0[q] & 0xffff0000u) : __uint_as_float(g0[q] << 16), c1 = hh ? __uint_as_float(g1[q] & 0xffff0000u) : __uint_as_float(g1[q] << 16), c2 = hh ? __uint_as_float(g2[q] & 0xffff0000u) : __uint_as_float(g2[q] << 16);
                const float cv = a0 * p.conv_w[ch] + a1 * p.conv_w[2 * DFF + ch] + a2 * p.conv_w[4 * DFF + ch] + p.conv_b[ch];
                const float cg = c0 * p.conv_w[DFF + ch] + c1 * p.conv_w[3 * DFF + ch] + c2 * p.conv_w[5 * DFF + ch] + p.conv_b[DFF + ch];
                res[hh] = gelu_tanh(cg) * cv; }
            ow[q] = pk2(res[0], res[1]); }
        *(u32x4*)(ACT + (size_t)R * DFF + hf * FH + j0) = (u32x4){ow[0], ow[1], ow[2], ow[3]};
    }
}

#define LAS __attribute__((address_space(3)))
#define XB_TMO      128
#define XB_XCNT(j)  (256  + 64 * (j))
#define XB_XSUB(j)  (1280 + 64 * (j))
#define XB_XGEN(j)  (2304 + 64 * (j))
#define XB_TOP      3328
#define XB_TOPGEN   3392
#define XCD_BAR_WORDS 3456
#define XB_SPIN_CAP (1u << 18)
__device__ __forceinline__ unsigned xb_ld(unsigned* p)              { return __hip_atomic_load(p, __ATOMIC_RELAXED, __HIP_MEMORY_SCOPE_AGENT); }
__device__ __forceinline__ unsigned xb_add(unsigned* p, unsigned v) { return __hip_atomic_fetch_add(p, v, __ATOMIC_RELAXED, __HIP_MEMORY_SCOPE_AGENT); }
__device__ __forceinline__ unsigned xb_xcc_id() { return (unsigned)__builtin_amdgcn_s_getreg((3 << 11) | 20) & 0xFu; }
#define XB_SPIN(cond, bar) do { unsigned _sp = 0; while (cond) { __builtin_amdgcn_s_sleep(1); \
    if ((++_sp & 255u) == 0u) { if (xb_ld(&(bar)[XB_TMO])) break; if (_sp > XB_SPIN_CAP) { atomicAdd(&(bar)[XB_TMO], 1u); break; } } } } while (0)
struct XcdBarrier { unsigned* bar; unsigned x; volatile LAS unsigned* st; };
__device__ __forceinline__ XcdBarrier xcd_barrier_post(unsigned* bar, volatile LAS unsigned* st) {
    XcdBarrier b; b.bar = bar; b.x = xb_xcc_id(); b.st = st;
    if (threadIdx.x == 0) (void)xb_add(&bar[XB_XCNT(b.x)], 1u);
    return b;
}
__device__ __forceinline__ void xcd_barrier_complete(unsigned* bar, unsigned x, unsigned& nloc, unsigned& nx) {
    const unsigned G = gridDim.x * gridDim.y * gridDim.z;
    unsigned sum, cnt, mine, sp = 0u;
    for (;;) {
        sum = 0u; cnt = 0u; mine = 0u;
#pragma unroll
        for (unsigned j = 0; j < 16; ++j) { const unsigned c = xb_ld(&bar[XB_XCNT(j)]); sum += c; cnt += (c > 0u) ? 1u : 0u; mine = (j == x) ? c : mine; }
        if (sum == G) break;
        __builtin_amdgcn_s_sleep(1);
        if ((++sp & 255u) == 0u) { if (xb_ld(&bar[XB_TMO])) break; if (sp > XB_SPIN_CAP) { atomicAdd(&bar[XB_TMO], 1u); break; } }
    }
    nloc = mine > 0u ? mine : 1u; nx = cnt > 0u ? cnt : 1u;
}
__device__ __forceinline__ void xcd_barrier(const XcdBarrier& b) {
    asm volatile("s_waitcnt vmcnt(0)" ::: "memory");
    __syncthreads();
    if (threadIdx.x == 0) {
        unsigned* bar = b.bar;
        __builtin_amdgcn_s_waitcnt(0);
        unsigned nloc = b.st[0], nx = b.st[1];
        if (nloc == 0u) { xcd_barrier_complete(bar, b.x, nloc, nx); b.st[0] = nloc; b.st[1] = nx; }
        const unsigned old = xb_add(&bar[XB_XSUB(b.x)], 1u);
        const unsigned gen = old / nloc;
        if (old + 1u == (gen + 1u) * nloc) {
            __builtin_amdgcn_fence(__ATOMIC_RELEASE, "agent");
            asm volatile("s_waitcnt vmcnt(0)" ::: "memory");
            const unsigned og = xb_add(&bar[XB_TOP], 1u);
            const unsigned tg = og / nx;
            if (og + 1u == (tg + 1u) * nx) xb_add(&bar[XB_TOPGEN], 1u);
            else XB_SPIN(xb_ld(&bar[XB_TOPGEN]) == tg, bar);
            __builtin_amdgcn_fence(__ATOMIC_ACQUIRE, "agent");
            xb_add(&bar[XB_XGEN(b.x)], 1u);
            asm volatile("s_waitcnt vmcnt(0)" ::: "memory");
        } else {
            XB_SPIN(xb_ld(&bar[XB_XGEN(b.x)]) == gen, bar);
            __builtin_amdgcn_fence(__ATOMIC_ACQUIRE, "agent");
            asm volatile("s_waitcnt vmcnt(0)" ::: "memory");
        }
    }
    __syncthreads();
}
constexpr int CW_BAR = 4096;
constexpr size_t CTL_ZERO_BYTES = 256 * 1024;

enum { PH_PREP = 0, PH_GEMM1, PH_GLA_DS, PH_NA_SCAN, PH_GLA_OUT, PH_WO, PH_ROWS1, PH_F1A, PH_ACTA, PH_F1B, PH_ACTB, PH_F2, PH_ROWS2, PH_COUNT };

__global__ void __launch_bounds__(NTHR, 2) fwd_kernel(Params p) {
    extern __shared__ __attribute__((aligned(16))) unsigned char lds[];
    const int nb = gridDim.x;
    const int vb = (nb % 8 == 0) ? (blockIdx.x % 8) * (nb / 8) + blockIdx.x / 8 : blockIdx.x;
    unsigned char* ws = p.ws;
    volatile LAS unsigned* MISC = (volatile LAS unsigned*)((LAS unsigned char*)lds + PH_LDS);
    if (threadIdx.x < 64) MISC[threadIdx.x] = 0u;
    __syncthreads();
    XcdBarrier bar = xcd_barrier_post((unsigned*)(ws + WS_CTL) + CW_BAR, MISC + 8);
    const int lo = p.ph_lo, hi = p.ph_hi;
#define IN(k) (lo <= (k) && (k) < hi)
#define SEAM(k) do { if (IN(k) && IN((k) + 1)) xcd_barrier(bar); } while (0)
    if (IN(PH_PREP)) { phase_prep(p, lds, vb, nb); } SEAM(PH_PREP);
    if (IN(PH_GEMM1)) { EpiPN e{(bf16_t*)(ws + WS_PN), (bf16_t*)(ws + WS_VT)};
        gemm_valu((const bf16_t*)(ws + WS_U), DM, (const bf16_t*)(ws + WS_WTN), DM, MR + NMETA, PN_VALID, DM, e, lds, vb, nb);
        EpiVT ev{(bf16_t*)(ws + WS_VT)};
        gemm_valu((const bf16_t*)(ws + WS_U), DM, (const bf16_t*)(ws + WS_WTV), DM, MR + NMETA, 1024, DM, ev, lds, vb, nb); } SEAM(PH_GEMM1);
    if (IN(PH_GLA_DS)) { phase_gla_ds(p, lds, vb, nb); } SEAM(PH_GLA_DS);
    if (IN(PH_NA_SCAN)) { phase_gla_scan(p, vb, nb); phase_na(p, lds, vb, nb); } SEAM(PH_NA_SCAN);
    if (IN(PH_GLA_OUT)) { phase_gla_out(p, lds, vb, nb); } SEAM(PH_GLA_OUT);
    if (IN(PH_WO)) { EpiF32S e{(float*)(ws + WS_Y), DM}; gemm_valu((const bf16_t*)(ws + WS_MIX), 1024, (const bf16_t*)(ws + WS_WTO), 1024, MX, DM, 1024, e, lds, vb, nb); } SEAM(PH_WO);
    if (IN(PH_ROWS1)) { phase_rows1(p, vb, nb); } SEAM(PH_ROWS1);
    if (IN(PH_F1A)) { EpiBF e{(bf16_t*)(ws + WS_ARAW), 2816}; gemm_valu((const bf16_t*)(ws + WS_U), DM, (const bf16_t*)(ws + WS_WF1), DM, MX, 2816, DM, e, lds, vb, nb); } SEAM(PH_F1A);
    if (IN(PH_ACTA)) { phase_act(p, 0, vb, nb); } SEAM(PH_ACTA);
    if (IN(PH_F1B)) { EpiBF e{(bf16_t*)(ws + WS_ARAW), 2816}; gemm_valu((const bf16_t*)(ws + WS_U), DM, (const bf16_t*)(ws + WS_WF1) + (size_t)2816 * 1024, DM, MX, 2816, DM, e, lds, vb, nb); } SEAM(PH_F1B);
    if (IN(PH_ACTB)) { phase_act(p, 1, vb, nb); } SEAM(PH_ACTB);
    if (IN(PH_F2)) { EpiF32S e{(float*)(ws + WS_Y), DM}; gemm_valu((const bf16_t*)(ws + WS_ACT), DFF, (const bf16_t*)(ws + WS_WF2), DFF, MR, DM, DFF, e, lds, vb, nb); } SEAM(PH_F2);
    if (IN(PH_ROWS2)) { phase_rows2(p, vb, nb); }
#undef IN
#undef SEAM
}

extern "C" void kernel_launch(void* const* d_in, const int* in_sizes, int n_in, void* d_out, int out_size, void* d_ws, size_t ws_size, hipStream_t stream) {
    static int grid = 0;
    if (grid == 0) {
        if (n_in != 19 || out_size != MR * DM || ws_size < 256 * MiB) { fprintf(stderr, "kernel_launch: unexpected shapes n_in %d out %d ws %zu\n", n_in, out_size, ws_size); grid = -1; return; }
        int dev = 0, cus = 0, per_cu = 0;
        if (hipGetDevice(&dev) != hipSuccess || hipDeviceGetAttribute(&cus, hipDeviceAttributeMultiprocessorCount, dev) != hipSuccess) { grid = -1; return; }
        if (hipFuncSetAttribute((const void*)fwd_kernel, hipFuncAttributeMaxDynamicSharedMemorySize, LDS_BYTES) != hipSuccess) { fprintf(stderr, "hipFuncSetAttribute failed\n"); grid = -1; return; }
        if (hipOccupancyMaxActiveBlocksPerMultiprocessor(&per_cu, (const void*)fwd_kernel, NTHR, LDS_BYTES) != hipSuccess || per_cu < 1) { fprintf(stderr, "occupancy query: %d\n", per_cu); }
        (void)hipGetLastError();
        grid = cus;
    }
    if (grid < 0) return;
    (void)hipMemsetAsync((char*)d_ws + WS_CTL, 0, CTL_ZERO_BYTES, stream);
    Params p{};
    p.x = (const float*)d_in[0]; p.meta = (const float*)d_in[1]; p.g_pre = (const float*)d_in[2]; p.w_in = (const float*)d_in[3]; p.rpb = (const float*)d_in[4]; p.na_gain = (const float*)d_in[5];
    p.up_f = (const float*)d_in[6]; p.bias_f = (const float*)d_in[7]; p.up_b = (const float*)d_in[8]; p.bias_b = (const float*)d_in[9]; p.gla_gain = (const float*)d_in[10]; p.w_o = (const float*)d_in[11];
    p.g_post = (const float*)d_in[12]; p.g_ffn_pre = (const float*)d_in[13]; p.w_f1 = (const float*)d_in[14]; p.conv_w = (const float*)d_in[15]; p.conv_b = (const float*)d_in[16]; p.w_f2 = (const float*)d_in[17]; p.g_ffn_post = (const float*)d_in[18];
    p.out = (float*)d_out; p.ws = (unsigned char*)d_ws; p.ph_lo = 0; p.ph_hi = PH_COUNT;
    hipLaunchKernelGGL(fwd_kernel, dim3(grid), dim3(NTHR), LDS_BYTES, stream, p);
}
```
